# Optimizing an MI355X kernel written in HIP

```python
import jax, jax.numpy as jnp
from jax import lax
import numpy as np

D_MODEL = 1024
BATCH = 8
SEQ = 2048
DEPTH = 4
DEC_BATCH = 128
DEC_SEQ = 8
PAST_LEN = 16384
PAGE_SIZE = 128

POOL_WINDOWS = (2, 4, 8, 16)
N_POOL_GROUPS = len(POOL_WINDOWS)
POOL_GROUP_DIM = D_MODEL // 8
WIDTH_A = N_POOL_GROUPS * POOL_GROUP_DIM
POOL_BUF = max(POOL_WINDOWS) - 1
CHUNK = 128
N_SGU_HEADS = 8
SGU_HEAD_DIM = D_MODEL // N_SGU_HEADS
WIDTH_B = N_SGU_HEADS * SGU_HEAD_DIM
D_FF = 4 * D_MODEL
D_IN = WIDTH_A + 2 * WIDTH_B + 2 * D_MODEL
EPS = 1e-6

kernel_name = "pool_sgu_gated_hybrid_step"


def rmsnorm(x, g):
    xf = x.astype(jnp.float32)
    y = xf * lax.rsqrt(jnp.mean(xf * xf, axis=-1, keepdims=True) + EPS)
    return (y * g.astype(jnp.float32)).astype(x.dtype)


def layernorm(x, g, b):
    xf = x.astype(jnp.float32)
    mu = jnp.mean(xf, axis=-1, keepdims=True)
    xc = xf - mu
    y = xc * lax.rsqrt(jnp.mean(xc * xc, axis=-1, keepdims=True) + EPS)
    return (y * g.astype(jnp.float32) + b.astype(jnp.float32)).astype(x.dtype)


def pool_mixer(a, buf, start_pos, w_pg, pool_scale):
    bsz, t_len, _ = a.shape
    ext = jnp.concatenate([buf, a], axis=1)
    cs = jnp.cumsum(ext.astype(jnp.float32), axis=1)
    cs = jnp.pad(cs, ((0, 0), (1, 0), (0, 0)))
    pos = start_pos + jnp.arange(t_len)
    hi = cs[:, POOL_BUF + 1:POOL_BUF + 1 + t_len]
    means = []
    for g, w in enumerate(POOL_WINDOWS):
        sl = slice(g * POOL_GROUP_DIM, (g + 1) * POOL_GROUP_DIM)
        lo = cs[:, POOL_BUF + 1 - w:POOL_BUF + 1 - w + t_len, sl]
        cnt = jnp.minimum(w, pos + 1).astype(jnp.float32)[None, :, None]
        means.append((hi[..., sl] - lo) / cnt)
    d = (jnp.concatenate(means, axis=-1) - a.astype(jnp.float32)).astype(a.dtype)
    d = d.reshape(bsz, t_len, N_POOL_GROUPS, POOL_GROUP_DIM)
    y = jnp.einsum('btgc,gcd->btgd', d, w_pg).reshape(bsz, t_len, WIDTH_A) * pool_scale
    return y, ext[:, -POOL_BUF:]


def spatial_gating(u, v, w_s, b_s, ln_g, ln_b):
    bsz, t_len, _ = v.shape
    v = layernorm(v, ln_g, ln_b)
    n_chunks = -(-t_len // CHUNK)
    pad = n_chunks * CHUNK - t_len
    vp = jnp.pad(v, ((0, 0), (0, pad), (0, 0))).reshape(bsz, n_chunks, CHUNK, N_SGU_HEADS, SGU_HEAD_DIM)
    mask = jnp.tril(jnp.ones((CHUNK, CHUNK), dtype=bool))
    wm = jnp.where(mask[None], w_s, jnp.zeros((), w_s.dtype))
    s = jnp.einsum('hts,bnshd->bnthd', wm, vp) + b_s.T[None, None, :, :, None]
    s = s.reshape(bsz, n_chunks * CHUNK, WIDTH_B)[:, :t_len]
    return u * s, v


def layer(x, buf, start_pos, w_in, w_pg, pool_scale, w_s, b_s, ln_g, ln_b,
          w_ba, w_bb, w_out, w_up, w_down, g_pre_mix, g_post_mix, g_pre_ffn, g_post_ffn):
    h = rmsnorm(x, g_pre_mix)
    z = h @ w_in
    c0 = WIDTH_A
    c1 = c0 + WIDTH_B
    c2 = c1 + WIDTH_B
    c3 = c2 + D_MODEL
    a, u, v, ga, gb = z[..., :c0], z[..., c0:c1], z[..., c1:c2], z[..., c2:c3], z[..., c3:]
    ya, new_buf = pool_mixer(a, buf, start_pos, w_pg, pool_scale)
    yb, v_rows = spatial_gating(jax.nn.gelu(u), jax.nn.gelu(v), w_s, b_s, ln_g, ln_b)
    m = jax.nn.sigmoid(ga) * (ya @ w_ba) + jax.nn.sigmoid(gb) * (yb @ w_bb)
    x = x + rmsnorm(m @ w_out, g_post_mix)
    f = jnp.square(jax.nn.relu(rmsnorm(x, g_pre_ffn) @ w_up)) @ w_down
    x = x + rmsnorm(f, g_post_ffn)
    return x, new_buf, v_rows


def setup_inputs(seed: int = 0) -> dict:
    key = jax.random.key(seed)
    ks = jax.random.split(key, 24)
    f32 = jnp.float32

    def nrm(k, shape, scale):
        return jax.random.normal(k, shape, f32) * scale

    return {
        "x_prompt": nrm(ks[0], (BATCH, SEQ, D_MODEL), 1.0),
        "x_sample": nrm(ks[1], (DEC_BATCH, DEC_SEQ, D_MODEL), 1.0),
        "state_pool": nrm(ks[2], (DEPTH, DEC_BATCH, POOL_BUF, WIDTH_A), 1.0),
        "w_in": nrm(ks[3], (DEPTH, D_MODEL, D_IN), D_MODEL ** -0.5),
        "w_pool_grp": nrm(ks[4], (DEPTH, N_POOL_GROUPS, POOL_GROUP_DIM, POOL_GROUP_DIM), POOL_GROUP_DIM ** -0.5),
        "pool_scale": 1.0 + nrm(ks[5], (DEPTH, WIDTH_A), 0.1),
        "w_spatial": nrm(ks[6], (DEPTH, N_SGU_HEADS, CHUNK, CHUNK), 0.1),
        "b_spatial": 1.0 + nrm(ks[7], (DEPTH, N_SGU_HEADS, CHUNK), 0.1),
        "ln_v_g": 1.0 + nrm(ks[8], (DEPTH, WIDTH_B), 0.05),
        "ln_v_b": nrm(ks[9], (DEPTH, WIDTH_B), 0.02),
        "w_branch_a": nrm(ks[10], (DEPTH, WIDTH_A, D_MODEL), WIDTH_A ** -0.5),
        "w_branch_b": nrm(ks[11], (DEPTH, WIDTH_B, D_MODEL), WIDTH_B ** -0.5),
        "w_out": nrm(ks[12], (DEPTH, D_MODEL, D_MODEL), D_MODEL ** -0.5),
        "w_up": nrm(ks[13], (DEPTH, D_MODEL, D_FF), D_MODEL ** -0.5),
        "w_down": nrm(ks[14], (DEPTH, D_FF, D_MODEL), D_FF ** -0.5),
        "g_pre_mix": 1.0 + nrm(ks[15], (DEPTH, D_MODEL), 0.05),
        "g_post_mix": 1.0 + nrm(ks[16], (DEPTH, D_MODEL), 0.05),
        "g_pre_ffn": 1.0 + nrm(ks[17], (DEPTH, D_MODEL), 0.05),
        "g_post_ffn": 1.0 + nrm(ks[18], (DEPTH, D_MODEL), 0.05),
    }


def reference(x_prompt, x_sample, state_pool, w_in, w_pool_grp, pool_scale, w_spatial, b_spatial,
              ln_v_g, ln_v_b, w_branch_a, w_branch_b, w_out, w_up, w_down,
              g_pre_mix, g_post_mix, g_pre_ffn, g_post_ffn):
    xp = x_prompt
    xs = x_sample
    buf_p0 = jnp.zeros((xp.shape[0], POOL_BUF, WIDTH_A), xp.dtype)
    pool_p, pool_s, v_s = [], [], []
    for l in range(DEPTH):
        params = (w_in[l], w_pool_grp[l], pool_scale[l], w_spatial[l], b_spatial[l], ln_v_g[l], ln_v_b[l],
                  w_branch_a[l], w_branch_b[l], w_out[l], w_up[l], w_down[l],
                  g_pre_mix[l], g_post_mix[l], g_pre_ffn[l], g_post_ffn[l])
        xp, bp, _ = layer(xp, buf_p0, 0, *params)
        xs, bs, vs = layer(xs, state_pool[l], PAST_LEN, *params)
        pool_p.append(bp)
        pool_s.append(bs)
        v_s.append(vs)
    state_pool_prompt = jnp.stack(pool_p)
    state_pool_sample = jnp.stack(pool_s)
    state_v_sample = jnp.stack(v_s)
    return (xp, xs, state_pool_prompt, state_pool_sample, state_v_sample)
```

```cpp
#include <hip/hip_runtime.h>
#include <hip/hip_cooperative_groups.h>
#include <cstdio>
namespace cg = cooperative_groups;

#ifndef MK_NOHOOK
#define MK_NOHOOK 0
#endif
#ifndef MK_SMASK
#define MK_SMASK 511
#endif
#define LAS __attribute__((address_space(3)))
typedef unsigned short bf16_t;
typedef short bf16x8 __attribute__((ext_vector_type(8)));
typedef float f32x4 __attribute__((ext_vector_type(4)));
typedef float f32x2 __attribute__((ext_vector_type(2)));
typedef unsigned u32x4 __attribute__((ext_vector_type(4)));
typedef unsigned u32x2 __attribute__((ext_vector_type(2)));

namespace {
constexpr int MP = 16384, MS = 1024, M = MP + MS;
constexpr int D = 1024, DIN = 4608, DFF = 4096, DEPTH = 4, WA = 512;
constexpr int KAB = 1536;
constexpr float EPS = 1e-6f;
constexpr size_t MiB = 1u << 20;
constexpr size_t WBLK = 31 * MiB;
constexpr size_t WOFF_IN = 0, WOFF_AB = 9 * MiB, WOFF_OUT = 12 * MiB, WOFF_UP = 14 * MiB, WOFF_DN = 22 * MiB, WOFF_SP = 30 * MiB;
constexpr size_t WS_XB = 62 * MiB;
constexpr size_t OUT_MSCR = 34 * MiB;
constexpr size_t WS_BIG = 96 * MiB, BIG_BLK = 2 * MiB;
constexpr size_t SEG_B = 512 * 1024;
constexpr size_t WS_AF = 232 * MiB, AF_BLK = 512 * 1024;
constexpr size_t WS_DY = 266 * MiB, DY_BLK = 768 * 1024;
constexpr size_t WS_RSA = 317 * MiB, WS_RSB = 317 * MiB + 128 * 1024, WS_LNP = 318 * MiB;
constexpr size_t WS_BAR = 321 * MiB, BAR_CNT_OFF = 65536, CTL_BYTES = 1 * MiB, WS_END = 322 * MiB;
enum { C_X = 0, C_G1 = 1, C_MIX = 2, C_G2 = 3, C_G3 = 4, C_R1 = 5, C_G4 = 6, C_G5 = 7, C_G1S = 8 };
constexpr int NPANEL = 68;
constexpr size_t OUT_X = 0, OUT_PP = (size_t)M * D, OUT_PS = OUT_PP + (size_t)DEPTH * 8 * 15 * WA, OUT_VS = OUT_PS + (size_t)DEPTH * 128 * 15 * WA;
constexpr int LDS_BYTES = 147456;

__device__ __forceinline__ unsigned cvt_pk_bf16(float lo, float hi) { unsigned r; asm volatile("v_cvt_pk_bf16_f32 %0, %1, %2" : "=v"(r) : "v"(lo), "v"(hi)); return r; }
template <int OFF> __device__ __forceinline__ void st16_wt(const void* sbase, unsigned voff, u32x4 v) {
    const __amdgpu_buffer_rsrc_t r = __builtin_amdgcn_make_buffer_rsrc((void*)sbase, 0, 0x40000000, 0x00020000); __builtin_amdgcn_raw_buffer_store_b128(v, r, voff + OFF, 0, 16); }
__device__ __forceinline__ void st8b_wt(const void* sbase, unsigned voff, u32x2 v) {
    const __amdgpu_buffer_rsrc_t r = __builtin_amdgcn_make_buffer_rsrc((void*)sbase, 0, 0x40000000, 0x00020000); __builtin_amdgcn_raw_buffer_store_b64(v, r, voff, 0, 16); }
__device__ __forceinline__ void st8_wt(void* p, f32x2 v) { asm volatile("global_store_dwordx2 %0, %1, off sc1" :: "v"(p), "v"(v) : "memory"); }
__device__ __forceinline__ float bf_lo(unsigned w) { return __uint_as_float(w << 16); }
__device__ __forceinline__ float bf_hi(unsigned w) { return __uint_as_float(w & 0xffff0000u); }
__device__ __forceinline__ float sigmoidf_(float x) { return __builtin_amdgcn_rcpf(1.0f + __builtin_amdgcn_exp2f(-1.44269504f * x)); }
__device__ __forceinline__ float gelu_tanh(float x) { const float y = 1.5957691216f * (x + 0.044715f * x * x * x); return x * sigmoidf_(y); }
__device__ __forceinline__ int lane_id() { int x; asm volatile("v_mbcnt_lo_u32_b32 %0, -1, 0\n\tv_mbcnt_hi_u32_b32 %0, -1, %0" : "=v"(x)); return x; }
__device__ __forceinline__ int launder_v(int x) { asm volatile("" : "+v"(x)); return x; }
__device__ __forceinline__ float shfl_xor_l(float v, int o, int lane) { return __int_as_float(__builtin_amdgcn_ds_bpermute(4 * (lane ^ o), __float_as_int(v))); }
__device__ __forceinline__ float wave_sum(float v, int lane) {
#pragma unroll
    for (int o = 1; o < 64; o <<= 1) v += shfl_xor_l(v, o, lane);
    return v;
}


#define XB_TMO      128
#define XB_XCNT(j)  (256  + 64 * (j))
#define XB_XSUB(j)  (1280 + 64 * (j))
#define XB_XGEN(j)  (2304 + 64 * (j))
#define XB_TOP      3328
#define XB_TOPGEN   3392
#define XCD_BAR_WORDS 3456
#define XB_SPIN_CAP (1u << 19)
__device__ __forceinline__ unsigned xb_ld(unsigned* p)              { return __hip_atomic_load(p, __ATOMIC_RELAXED, __HIP_MEMORY_SCOPE_AGENT); }
__device__ __forceinline__ unsigned xb_add(unsigned* p, unsigned v) { return __hip_atomic_fetch_add(p, v, __ATOMIC_RELAXED, __HIP_MEMORY_SCOPE_AGENT); }
__device__ __forceinline__ unsigned xb_xcc_id() { return (unsigned)__builtin_amdgcn_s_getreg((3 << 11) | 20) & 0xFu; }
#define XB_SPIN(cond, bar) do { unsigned _sp = 0; while (cond) { __builtin_amdgcn_s_sleep(1); \
    if ((++_sp & 255u) == 0u) { if (xb_ld(&(bar)[XB_TMO])) break; if (_sp > XB_SPIN_CAP) { atomicAdd(&(bar)[XB_TMO], 1u); break; } } } } while (0)
struct XcdBarrier { unsigned* bar; unsigned x; volatile LAS unsigned* st; };
__device__ __forceinline__ XcdBarrier xcd_barrier_post(unsigned* bar, volatile LAS unsigned* st) {
    XcdBarrier b; b.bar = bar; b.x = xb_xcc_id(); b.st = st;
    if (threadIdx.x == 0) (void)xb_add(&bar[XB_XCNT(b.x)], 1u);
    return b;
}
__device__ __forceinline__ void xcd_barrier_complete(unsigned* bar, unsigned x, unsigned& nloc, unsigned& nx) {
    const unsigned G = gridDim.x * gridDim.y * gridDim.z;
    unsigned sum, cnt, mine, sp = 0u;
    for (;;) {
        sum = 0u; cnt = 0u; mine = 0u;
#pragma unroll
        for (unsigned j = 0; j < 16; ++j) { const unsigned c = xb_ld(&bar[XB_XCNT(j)]); sum += c; cnt += (c > 0u) ? 1u : 0u; mine = (j == x) ? c : mine; }
        if (sum == G) break;
        __builtin_amdgcn_s_sleep(1);
        if ((++sp & 255u) == 0u) { if (xb_ld(&bar[XB_TMO])) break; if (sp > XB_SPIN_CAP) { atomicAdd(&bar[XB_TMO], 1u); break; } }
    }
    nloc = mine > 0u ? mine : 1u; nx = cnt > 0u ? cnt : 1u;
}
__device__ __forceinline__ void xcd_barrier(unsigned* bar_, volatile LAS unsigned* st_, int tid) {
    XcdBarrier b; b.bar = bar_; b.x = xb_xcc_id(); b.st = st_;
    asm volatile("s_waitcnt vmcnt(0)" ::: "memory");
    __syncthreads();
    if (tid == 0) {
        unsigned* bar = b.bar;
        __builtin_amdgcn_s_waitcnt(0);
        unsigned nloc = b.st[0], nx = b.st[1];
        if (nloc == 0u) { xcd_barrier_complete(bar, b.x, nloc, nx); b.st[0] = nloc; b.st[1] = nx; }
        const unsigned old = xb_add(&bar[XB_XSUB(b.x)], 1u);
        const unsigned gen = old / nloc;
        if (old + 1u == (gen + 1u) * nloc) {
            __builtin_amdgcn_fence(__ATOMIC_RELEASE, "agent");
            asm volatile("s_waitcnt vmcnt(0)" ::: "memory");
            const unsigned og = xb_add(&bar[XB_TOP], 1u);
            const unsigned tg = og / nx;
            if (og + 1u == (tg + 1u) * nx) xb_add(&bar[XB_TOPGEN], 1u);
            else XB_SPIN(xb_ld(&bar[XB_TOPGEN]) == tg, bar);
            __builtin_amdgcn_fence(__ATOMIC_ACQUIRE, "agent");
            xb_add(&bar[XB_XGEN(b.x)], 1u);
            asm volatile("s_waitcnt vmcnt(0)" ::: "memory");
        } else {
            XB_SPIN(xb_ld(&bar[XB_XGEN(b.x)]) == gen, bar);
            __builtin_amdgcn_fence(__ATOMIC_ACQUIRE, "agent");
            asm volatile("s_waitcnt vmcnt(0)" ::: "memory");
        }
    }
    __syncthreads();
}

struct Dep { unsigned* cl; unsigned* tmo; const unsigned* prevmix; const unsigned* prep; unsigned nprep; };
__device__ __forceinline__ unsigned* cnt_ptr(unsigned char* ws, int l, int stage) { return (unsigned*)(ws + WS_BAR + BAR_CNT_OFF) + (size_t)((l * 9 + stage) * NPANEL) * 64; }
__device__ __forceinline__ void dep_wait1(const unsigned* w, unsigned need, unsigned* tmo, int tid) {
    unsigned polls = 0;
    while ((unsigned)__builtin_amdgcn_readfirstlane(__hip_atomic_load(w, __ATOMIC_RELAXED, __HIP_MEMORY_SCOPE_AGENT)) < need) {
        if ((++polls & 255u) == 0u) { if (__builtin_amdgcn_readfirstlane(__hip_atomic_load(tmo, __ATOMIC_RELAXED, __HIP_MEMORY_SCOPE_AGENT)) != 0u) break;
            if (polls > (1u << 17)) { if (tid == 0) __hip_atomic_store(tmo, 1u, __ATOMIC_RELAXED, __HIP_MEMORY_SCOPE_AGENT); break; } }
        __builtin_amdgcn_s_sleep(2); }
}
__device__ __forceinline__ void dep_wait(const unsigned* w, unsigned need, unsigned* tmo, int tid) {
    if (tid < 64) { dep_wait1(w, need, tmo, tid); __builtin_amdgcn_fence(__ATOMIC_ACQUIRE, "agent"); asm volatile("s_waitcnt vmcnt(0)" ::: "memory"); }
    asm volatile("" ::: "memory"); __builtin_amdgcn_s_barrier(); asm volatile("" ::: "memory");
}
__device__ __forceinline__ void dep_wait2(const unsigned* w0, const unsigned* w1, unsigned need, unsigned* tmo, int tid) {
    if (tid < 64) { dep_wait1(w0, need, tmo, tid); dep_wait1(w1, need, tmo, tid); __builtin_amdgcn_fence(__ATOMIC_ACQUIRE, "agent"); asm volatile("s_waitcnt vmcnt(0)" ::: "memory"); }
    asm volatile("" ::: "memory"); __builtin_amdgcn_s_barrier(); asm volatile("" ::: "memory");
}
template <class Sel>
__device__ __forceinline__ void dep_wait_many(const unsigned* cbase, int n, unsigned need, unsigned* tmo, int tid, const Sel& sel) {
    if (tid < 64) { unsigned polls = 0;
        for (;;) { const unsigned a = tid < n ? __hip_atomic_load(cbase + 64 * sel(tid), __ATOMIC_RELAXED, __HIP_MEMORY_SCOPE_AGENT) : need;
            const unsigned b = tid + 64 < n ? __hip_atomic_load(cbase + 64 * sel(tid + 64), __ATOMIC_RELAXED, __HIP_MEMORY_SCOPE_AGENT) : need;
            if (__all(a >= need && b >= need)) break;
            if ((++polls & 255u) == 0u) { if (__builtin_amdgcn_readfirstlane(__hip_atomic_load(tmo, __ATOMIC_RELAXED, __HIP_MEMORY_SCOPE_AGENT)) != 0u) break;
                if (polls > (1u << 17)) { if (tid == 0) __hip_atomic_store(tmo, 1u, __ATOMIC_RELAXED, __HIP_MEMORY_SCOPE_AGENT); break; } }
            __builtin_amdgcn_s_sleep(2); }
        __builtin_amdgcn_fence(__ATOMIC_ACQUIRE, "agent"); asm volatile("s_waitcnt vmcnt(0)" ::: "memory"); }
    asm volatile("" ::: "memory"); __builtin_amdgcn_s_barrier(); asm volatile("" ::: "memory");
}
__device__ __forceinline__ void dep_wait3(const unsigned* w0, unsigned n0, const unsigned* w1, unsigned n1, const unsigned* w2, unsigned n2, unsigned* tmo, int tid) {
    if (tid < 64) { dep_wait1(w0, n0, tmo, tid); dep_wait1(w1, n1, tmo, tid); dep_wait1(w2, n2, tmo, tid); __builtin_amdgcn_fence(__ATOMIC_ACQUIRE, "agent"); asm volatile("s_waitcnt vmcnt(0)" ::: "memory"); }
    asm volatile("" ::: "memory"); __builtin_amdgcn_s_barrier(); asm volatile("" ::: "memory");
}
__device__ __forceinline__ void dep_done_wt(unsigned* c, int tid, unsigned inc = 1u) {
    asm volatile("s_waitcnt vmcnt(0)" ::: "memory"); __builtin_amdgcn_s_barrier(); asm volatile("" ::: "memory");
    if (tid == 0) __hip_atomic_fetch_add(c, inc, __ATOMIC_RELAXED, __HIP_MEMORY_SCOPE_AGENT);
}
__device__ __forceinline__ void dep_done(unsigned* c, int tid) {
    asm volatile("s_waitcnt vmcnt(0)" ::: "memory"); __builtin_amdgcn_s_barrier(); asm volatile("" ::: "memory");
    if (tid == 0) { __builtin_amdgcn_fence(__ATOMIC_RELEASE, "agent"); asm volatile("s_waitcnt vmcnt(0)" ::: "memory"); __hip_atomic_fetch_add(c, 1u, __ATOMIC_RELAXED, __HIP_MEMORY_SCOPE_AGENT); }
}

constexpr int BM = 256, BK = 64, HALF = 128, HTB = HALF * BK * 2, NXCD = 8, WGM = 8;
__device__ __forceinline__ int lds_byte(int r, int c) { const int st = (r >> 4) * 2 + (c >> 5), rr = r & 15, cc = c & 31, ob = rr * 64 + cc * 2; return st * 1024 + (ob ^ (((ob >> 9) & 1) << 5)); }
__device__ __forceinline__ void stage_rc(int b, int& R, int& C) { const int st = b / 1024, sb = b % 1024, swz = sb ^ (((sb >> 9) & 1) << 5); R = (st >> 1) * 16 + swz / 64; C = (st & 1) * 32 + (swz % 64) / 2; }
__device__ __forceinline__ int perm32(int rho) { const int n = rho >> 4, i = rho & 15; return 8 * (i >> 2) + 4 * n + (i & 3); }

struct Unit { int pm, pn, sub; };
__device__ __forceinline__ bool tile_of(long L, int nM, int nN, int& pm, int& pn) {
    const int nwg = nM * nN; if (L >= nwg) return false;
    int wgid = (int)L; { const int q = nwg / NXCD, r = nwg % NXCD, xcd = wgid % NXCD, off = wgid / NXCD; wgid = (xcd < r ? xcd * (q + 1) : r * (q + 1) + (xcd - r) * q) + off; }
    const int nig = WGM * nN, gid = wgid / nig, fm = gid * WGM, gsz = (nM - fm) < WGM ? (nM - fm) : WGM;
    pm = fm + ((wgid % nig) % gsz); pn = (wgid % nig) / gsz; return true;
}
template <int MODE, int SCHED>
__device__ __forceinline__ bool get_unit(int i, int G, int c, int nM, int nN, int NT, Unit& u, int& kofs, int& nt) {
    const int round = MODE == 1 ? (i >> 1) : i;
    if (MODE == 1) { u.sub = i & 1; kofs = u.sub * 512; nt = u.sub ? 16 : 8; } else { u.sub = 0; kofs = 0; nt = NT; }
    if (SCHED == 0 || G != 256) return tile_of((long)round * G + c, nM, nN, u.pm, u.pn);
    const int v = (c & 7) * 32 + (c >> 3), h = v >> 4, p = v - h - 1; const bool heavy = (v & 15) == 0;
    if (SCHED == 6) {
        const int x = v >> 5, w32 = v & 31, pos = round * 32 + w32; if (pos >= 153) return false;
        if (pos < 9) { const int e = x * 9 + pos; u.pm = 64 + e / 18; u.pn = e % 18; } else { const int i = pos - 9; u.pn = i >> 3; u.pm = 8 * x + (i & 7); }
        return true;
    }
    if (SCHED == 1) {
        if (heavy) return false;
        const int x = p / 30, q = p - 30 * x, tl = round * 30 + q; if (tl >= 136) return false;
        u.pm = tl >> 1; u.pn = 2 * x + (tl & 1); return true;
    } else if (SCHED == 2) {
        int j;
        if (heavy) { if (round >= 2) return false; j = h * 2 + round; }
        else { if (round >= 1) return false; const int x = p / 30, q = p - 30 * x; j = (q >= 16) ? 32 + x * 14 + (q - 16) : 144 + x * 16 + q; }
        u.pm = j >> 2; u.pn = j & 3; return true;
    } else if (SCHED == 3) {
        int j;
        if (heavy) { if (round >= 2) return false; j = 240 + round * 16 + h; } else { if (round >= 1) return false; j = p; }
        u.pm = j >> 2; u.pn = j & 3; return true;
    } else {
        if (heavy) return false;
        int j;
        if (round == 0) j = p; else if (round == 1 && p < 32) j = 240 + p; else return false;
        u.pm = j >> 2; u.pn = j & 3; return true;
    }
}

template <int MODE, int SCHED, int WST, int NEED, int DST, class Epi>
__device__ __forceinline__ void gemm_phase(const int wid_, LAS unsigned char* lds, const bf16_t* Ab, const size_t tstepA, const bf16_t* Bb, const int ld, const int nM, const int nN, const Epi& E, const Dep& dep) {
    const int wid = wid_, lane = launder_v(lane_id()), tid = wid * 64 + lane, wr = wid >> 2, wc = wid & 3, fr = lane & 15, fq = lane >> 4;
    const int G = gridDim.x, c = blockIdx.x;
    unsigned voffA[2], voffB[2];
#pragma unroll
    for (int i = 0; i < 2; ++i) { int R, C; stage_rc(tid * 16 + i * 8192, R, C); const int Rb = (R & ~31) + perm32(R & 31);
        voffA[i] = (unsigned)(R * ld + C) * 2u; voffB[i] = (unsigned)(Rb * ld + C) * 2u; }
    const size_t kstep = (size_t)(BK * 2);
    const size_t hstep = (size_t)HALF * ld * 2, tstepB = 2 * hstep;
    const int NT = ld / BK;
    const unsigned ldsw = (unsigned)wid * 1024u;
    const int aoff = lds_byte(wr * 64 + fr, fq * 8), boff = lds_byte(wc * 32 + fr, fq * 8);
#define PG8_SA(b, h) (((b) * 2 + (h)) * HTB)
#define PG8_SB(b, h) ((4 + (b) * 2 + (h)) * HTB)
#define PG8_STAGE(bufoff, gbase, voff) do { _Pragma("unroll") for (int _i = 0; _i < 2; ++_i) \
        __builtin_amdgcn_global_load_lds((const unsigned*)((const char*)(gbase) + (voff)[_i]), (LAS unsigned*)(lds + (bufoff) + ldsw + _i * 8192), 16, 0, 0); } while (0)
#define PG8_LDA(dst, b, h) do { _Pragma("unroll") for (int m = 0; m < 4; ++m) _Pragma("unroll") for (int k = 0; k < 2; ++k) dst[m][k] = *(const LAS bf16x8*)(lds + PG8_SA(b, h) + aoff + m * 2048 + k * 1024); } while (0)
#define PG8_LDB(dst, b, h) do { _Pragma("unroll") for (int n = 0; n < 2; ++n) _Pragma("unroll") for (int k = 0; k < 2; ++k) dst[n][k] = *(const LAS bf16x8*)(lds + PG8_SB(b, h) + boff + n * 2048 + k * 1024); } while (0)
#define PG8_MMA(ai, bj, At, Bt) do { __builtin_amdgcn_s_setprio(1); _Pragma("unroll") for (int m = 0; m < 4; ++m) _Pragma("unroll") for (int n = 0; n < 2; ++n) _Pragma("unroll") for (int k = 0; k < 2; ++k) \
        acc[ai][bj][m][n] = __builtin_amdgcn_mfma_f32_16x16x32_bf16(Bt[n][k], At[m][k], acc[ai][bj][m][n], 0, 0, 0); __builtin_amdgcn_s_setprio(0); } while (0)
#define PG8_WAIT_V(n) asm volatile("s_waitcnt vmcnt(" #n ")" ::: "memory")
#define PG8_WAIT_L(n) asm volatile("s_waitcnt lgkmcnt(" #n ")" ::: "memory")
#define PG8_BAR __builtin_amdgcn_s_barrier()
#define PG8_SCHED __builtin_amdgcn_sched_barrier(0)
    Unit cur, nxt; int ui = 0, kofs, nt, nkofs = 0, nnt = 0, pend = -1;
    if (!get_unit<MODE, SCHED>(0, G, c, nM, nN, NT, cur, kofs, nt)) return;
    f32x4 acc[2][2][4][2];
#pragma unroll
    for (int a = 0; a < 2; ++a)
#pragma unroll
        for (int b = 0; b < 2; ++b)
#pragma unroll
            for (int m = 0; m < 4; ++m)
#pragma unroll
                for (int n = 0; n < 2; ++n) acc[a][b][m][n] = (f32x4){0.f, 0.f, 0.f, 0.f};
    bf16x8 At[4][2], B0[2][2], B1[2][2];
    const char* cA = (const char*)Ab + (size_t)cur.pm * tstepA + (size_t)kofs * 2; const char* cB = (const char*)Bb + (size_t)cur.pn * tstepB + (size_t)kofs * 2;
    if (NEED > 0) { if (WST == C_X) { const int q = cur.pm + 1 < NPANEL ? cur.pm + 1 : cur.pm; dep_wait3(dep.cl + (WST * NPANEL + cur.pm) * 64, (unsigned)NEED, dep.prevmix + 64 * q, dep.prevmix == dep.prep ? 0u : 24u, dep.prep, dep.nprep, dep.tmo, tid); }
                    else if (WST == C_MIX) dep_wait3(dep.cl + (WST * NPANEL + cur.pm) * 64, (unsigned)NEED, dep.cl + (C_G1S * NPANEL + cur.pm) * 64, 64u, dep.cl + (C_G1S * NPANEL + cur.pm) * 64, 64u, dep.tmo, tid);
                    else dep_wait(dep.cl + (WST * NPANEL + cur.pm) * 64, (unsigned)NEED, dep.tmo, tid); }
    PG8_STAGE(PG8_SB(0, 0), cB, voffB); PG8_STAGE(PG8_SB(0, 1), cB + hstep, voffB); PG8_STAGE(PG8_SA(0, 0), cA, voffA); PG8_STAGE(PG8_SA(0, 1), cA + hstep, voffA);
    if (wr == 1) PG8_BAR;
    PG8_WAIT_V(2); PG8_BAR;
    PG8_STAGE(PG8_SB(1, 0), cB + kstep, voffB); PG8_STAGE(PG8_SA(1, 0), cA + kstep, voffA); PG8_STAGE(PG8_SB(1, 1), cB + hstep + kstep, voffB);
    PG8_WAIT_V(6); PG8_BAR;
    for (;;) {
        const bool has_next = get_unit<MODE, SCHED>(ui + 1, G, c, nM, nN, NT, nxt, nkofs, nnt);
        const char* nA = has_next ? (const char*)Ab + (size_t)nxt.pm * tstepA + (size_t)nkofs * 2 : cA; const char* nB = has_next ? (const char*)Bb + (size_t)nxt.pn * tstepB + (size_t)nkofs * 2 : cB;
        const int ntc = MODE == 0 ? NT : nt;
        for (int t = 0; t < ntc; t += 2) {
            const bool last = (t == ntc - 2);
            const char* a1 = cA + (size_t)(t + 1) * kstep;
            const char* a2 = last ? nA : cA + (size_t)(t + 2) * kstep; const char* b2 = last ? nB : cB + (size_t)(t + 2) * kstep;
            const char* a3 = a2 + kstep; const char* b3 = b2 + kstep;
#if !MK_NOHOOK
            if (NEED > 0 && last && has_next && (MODE == 0 || nxt.sub == 0)) { if (WST == C_X) { const int q = nxt.pm + 1 < NPANEL ? nxt.pm + 1 : nxt.pm; dep_wait3(dep.cl + (WST * NPANEL + nxt.pm) * 64, (unsigned)NEED, dep.prevmix + 64 * q, dep.prevmix == dep.prep ? 0u : 24u, dep.prep, dep.nprep, dep.tmo, tid); }
                else if (WST == C_MIX) dep_wait3(dep.cl + (WST * NPANEL + nxt.pm) * 64, (unsigned)NEED, dep.cl + (C_G1S * NPANEL + nxt.pm) * 64, 64u, dep.cl + (C_G1S * NPANEL + nxt.pm) * 64, 64u, dep.tmo, tid);
                else dep_wait(dep.cl + (WST * NPANEL + nxt.pm) * 64, (unsigned)NEED, dep.tmo, tid); }
#endif
            PG8_LDB(B0, 0, 0); PG8_LDB(B1, 0, 1); PG8_SCHED; PG8_LDA(At, 0, 0); PG8_STAGE(PG8_SA(1, 1), a1 + hstep, voffA);
            PG8_WAIT_V(8); PG8_WAIT_L(0); PG8_BAR; PG8_MMA(0, 0, At, B0); PG8_MMA(0, 1, At, B1); PG8_BAR; PG8_SCHED;
            PG8_LDA(At, 0, 1); PG8_STAGE(PG8_SB(0, 0), b2, voffB); PG8_STAGE(PG8_SB(0, 1), b2 + hstep, voffB); PG8_STAGE(PG8_SA(0, 0), a2, voffA);
            PG8_WAIT_V(8); PG8_WAIT_L(0); PG8_BAR; PG8_MMA(1, 0, At, B0); PG8_MMA(1, 1, At, B1); PG8_BAR; PG8_SCHED;
            PG8_LDB(B0, 1, 0); PG8_LDB(B1, 1, 1); PG8_SCHED; PG8_LDA(At, 1, 0); PG8_STAGE(PG8_SA(0, 1), a2 + hstep, voffA);
            PG8_WAIT_V(8); PG8_WAIT_L(0); PG8_BAR; PG8_MMA(0, 0, At, B0); PG8_MMA(0, 1, At, B1); PG8_BAR; PG8_SCHED;
            PG8_LDA(At, 1, 1); PG8_STAGE(PG8_SB(1, 0), b3, voffB); PG8_STAGE(PG8_SB(1, 1), b3 + hstep, voffB); PG8_STAGE(PG8_SA(1, 0), a3, voffA);
            PG8_WAIT_V(8); PG8_WAIT_L(0); PG8_BAR; PG8_MMA(1, 0, At, B0); PG8_MMA(1, 1, At, B1); PG8_BAR; PG8_SCHED;
        }
        if (wr == 0) PG8_BAR;
        if (DST >= 0 && pend >= 0) { PG8_WAIT_V(0); if (lane_id() == 0) __hip_atomic_fetch_add(dep.cl + (DST * NPANEL + pend) * 64, 1u, __ATOMIC_RELAXED, __HIP_MEMORY_SCOPE_AGENT); pend = -1; }
        E(acc, cur, wr, wc, lane);
        if (DST >= 0 && (MODE == 0 || cur.sub == 1)) {
            if (SCHED == 1 && ui == 0) { PG8_WAIT_V(0); if (lane_id() == 0) __hip_atomic_fetch_add(dep.cl + (DST * NPANEL + cur.pm) * 64, 1u, __ATOMIC_RELAXED, __HIP_MEMORY_SCOPE_AGENT); }
            else pend = cur.pm + ((DST == C_G1 && cur.pn >= 10) ? (C_G1S - C_G1) * NPANEL : 0); }
        if (!has_next) break;
        if (MODE == 0 || cur.sub == 1)
#pragma unroll
        for (int a = 0; a < 2; ++a)
#pragma unroll
            for (int b = 0; b < 2; ++b)
#pragma unroll
                for (int m = 0; m < 4; ++m)
#pragma unroll
                    for (int n = 0; n < 2; ++n) acc[a][b][m][n] = (f32x4){0.f, 0.f, 0.f, 0.f};
        cur = nxt; cA = nA; cB = nB; nt = nnt; ++ui;
        if (wr == 1) PG8_BAR;
    }
    PG8_WAIT_V(0);
    if (DST >= 0 && pend >= 0 && lane_id() == 0) __hip_atomic_fetch_add(dep.cl + (DST * NPANEL + pend) * 64, 1u, __ATOMIC_RELAXED, __HIP_MEMORY_SCOPE_AGENT);
    PG8_BAR;
#undef PG8_SA
#undef PG8_SB
#undef PG8_STAGE
#undef PG8_LDA
#undef PG8_LDB
#undef PG8_MMA
#undef PG8_WAIT_V
#undef PG8_WAIT_L
#undef PG8_BAR
#undef PG8_SCHED
}

struct EpiIn {
    unsigned char* ws;
    __device__ __forceinline__ void operator()(const f32x4 (&acc)[2][2][4][2], const Unit& u, int wr, int wc, int lane_) const {
        const int ln = launder_v(lane_), fr = ln & 15, fq = ln >> 4;
        const int lr0 = wr * 64 + fr, cw = wc * 32 + 8 * fq, pn = u.pn;
        const float* rstd = (const float*)(ws + WS_RSA) + u.pm * BM; float* lnpart = (float*)(ws + WS_LNP);
        float rsv[2][4];
#pragma unroll
        for (int ai = 0; ai < 2; ++ai)
#pragma unroll
            for (int m = 0; m < 4; ++m) rsv[ai][m] = rstd[lr0 + ai * HALF + m * 16];
        if (pn < 2) {
            bf16_t* ab = (bf16_t*)(ws + WS_AF + (size_t)u.pm * AF_BLK);
#pragma unroll
            for (int ai = 0; ai < 2; ++ai)
#pragma unroll
                for (int m = 0; m < 4; ++m) { const int lr = lr0 + ai * HALF + m * 16; const float rs = rsv[ai][m];
#pragma unroll
                    for (int bj = 0; bj < 2; ++bj) { const f32x4 v0 = acc[ai][bj][m][0] * rs, v1 = acc[ai][bj][m][1] * rs;
                        u32x4 w; w.x = cvt_pk_bf16(v0[0], v0[1]); w.y = cvt_pk_bf16(v0[2], v0[3]); w.z = cvt_pk_bf16(v1[0], v1[1]); w.w = cvt_pk_bf16(v1[2], v1[3]);
                        { const unsigned vo = (unsigned)(lr * WA + pn * BM + cw) * 2u; if (bj == 0) st16_wt<0>(ab, vo, w); else st16_wt<256>(ab, vo, w); } }
                    asm volatile("" ::: "memory"); }
        } else {
            const int seg = (pn - 2) >> 2, colb = ((pn - 2) & 3) * BM + cw;
            bf16_t* O = (bf16_t*)(ws + WS_BIG + (size_t)u.pm * BIG_BLK + (size_t)seg * SEG_B);
            if (seg < 2) {
#pragma unroll
                for (int ai = 0; ai < 2; ++ai)
#pragma unroll
                    for (int m = 0; m < 4; ++m) { const int lr = lr0 + ai * HALF + m * 16, gr = u.pm * BM + lr; const float rs = rsv[ai][m]; const unsigned vo = (unsigned)(lr * D + colb) * 2u;
                        float s1 = 0.f, s2 = 0.f;
#pragma unroll
                        for (int bj = 0; bj < 2; ++bj) { float v[8];
#pragma unroll
                            for (int j = 0; j < 4; ++j) { v[j] = acc[ai][bj][m][0][j] * rs; v[4 + j] = acc[ai][bj][m][1][j] * rs; }
#pragma unroll
                            for (int j = 0; j < 8; ++j) { const float x = v[j], e = x * (-0.102943240f * (x * x) + -2.30220819f); v[j] = x * __builtin_amdgcn_rcpf(1.0f + __builtin_amdgcn_exp2f(e)); s1 += v[j]; s2 += v[j] * v[j]; }
                            u32x4 w; w.x = cvt_pk_bf16(v[0], v[1]); w.y = cvt_pk_bf16(v[2], v[3]); w.z = cvt_pk_bf16(v[4], v[5]); w.w = cvt_pk_bf16(v[6], v[7]);
                            if (bj == 0) st16_wt<0>(O, vo, w); else st16_wt<256>(O, vo, w); }
                        if (seg == 1) { s1 += shfl_xor_l(s1, 16, ln); s1 += shfl_xor_l(s1, 32, ln); s2 += shfl_xor_l(s2, 16, ln); s2 += shfl_xor_l(s2, 32, ln);
                            if (fq == 0) st8_wt(lnpart + ((size_t)gr * 16 + (pn - 6) * 4 + wc) * 2, (f32x2){s1, s2}); }
                        asm volatile("" ::: "memory"); }
            } else {
#pragma unroll
                for (int ai = 0; ai < 2; ++ai)
#pragma unroll
                    for (int m = 0; m < 4; ++m) { const int lr = lr0 + ai * HALF + m * 16; const float rs = rsv[ai][m] * -1.44269504f; bf16_t* rowp = O + (size_t)lr * D + colb;
#pragma unroll
                        for (int bj = 0; bj < 2; ++bj) { float v[8];
#pragma unroll
                            for (int j = 0; j < 4; ++j) { v[j] = acc[ai][bj][m][0][j] * rs; v[4 + j] = acc[ai][bj][m][1][j] * rs; }
#pragma unroll
                            for (int j = 0; j < 8; ++j) v[j] = __builtin_amdgcn_rcpf(1.0f + __builtin_amdgcn_exp2f(v[j]));
                            u32x4 w; w.x = cvt_pk_bf16(v[0], v[1]); w.y = cvt_pk_bf16(v[2], v[3]); w.z = cvt_pk_bf16(v[4], v[5]); w.w = cvt_pk_bf16(v[6], v[7]);
                            if (bj == 0) st16_wt<0>(O, (unsigned)(lr * D + colb) * 2u, w); else st16_wt<256>(O, (unsigned)(lr * D + colb) * 2u, w); } }
            }
        }
    }
};
struct EpiAB {
    unsigned char* ws; unsigned char* mscr;
    __device__ __forceinline__ void operator()(f32x4 (&acc)[2][2][4][2], const Unit& u, int wr, int wc, int lane_) const {
        const int ln = launder_v(lane_), fr = ln & 15, fq = ln >> 4;
        const int lr0 = wr * 64 + fr, col0 = u.pn * BM + wc * 32 + 8 * fq;
        const bf16_t* SA = (const bf16_t*)(ws + WS_BIG + (size_t)u.pm * BIG_BLK + 2 * SEG_B); const bf16_t* SB = SA + SEG_B / 2;
        bf16_t* mo = (bf16_t*)mscr + (size_t)u.pm * BM * D;
#pragma unroll
        for (int ai = 0; ai < 2; ++ai) {
            u32x4 gb[4][2], ga[4][2];
#pragma unroll
            for (int m = 0; m < 4; ++m)
#pragma unroll
                for (int bj = 0; bj < 2; ++bj) { const size_t off = (size_t)(lr0 + ai * HALF + m * 16) * D + col0 + bj * HALF; gb[m][bj] = *(const u32x4*)(SB + off); if (u.sub == 0) ga[m][bj] = *(const u32x4*)(SA + off); }
#pragma unroll
            for (int m = 0; m < 4; ++m)
#pragma unroll
                for (int bj = 0; bj < 2; ++bj) { const size_t off = (size_t)(lr0 + ai * HALF + m * 16) * D + col0 + bj * HALF; const u32x4 b = gb[m][bj];
                    f32x4 s0 = (f32x4){bf_lo(b.x), bf_hi(b.x), bf_lo(b.y), bf_hi(b.y)}, s1 = (f32x4){bf_lo(b.z), bf_hi(b.z), bf_lo(b.w), bf_hi(b.w)};
#pragma unroll
                    for (int j = 0; j < 4; ++j) { s0[j] = fmaxf(s0[j], 1e-30f); s1[j] = fmaxf(s1[j], 1e-30f); }
                    if (u.sub == 0) { const u32x4 a = ga[m][bj];
#pragma unroll
                        for (int j = 0; j < 4; ++j) { s0[j] = __builtin_amdgcn_rcpf(s0[j]); s1[j] = __builtin_amdgcn_rcpf(s1[j]); }
                        acc[ai][bj][m][0] = acc[ai][bj][m][0] * (s0 * (f32x4){bf_lo(a.x), bf_hi(a.x), bf_lo(a.y), bf_hi(a.y)});
                        acc[ai][bj][m][1] = acc[ai][bj][m][1] * (s1 * (f32x4){bf_lo(a.z), bf_hi(a.z), bf_lo(a.w), bf_hi(a.w)});
                    } else { const f32x4 v0 = acc[ai][bj][m][0] * s0, v1 = acc[ai][bj][m][1] * s1;
                        u32x4 w; w.x = cvt_pk_bf16(v0[0], v0[1]); w.y = cvt_pk_bf16(v0[2], v0[3]); w.z = cvt_pk_bf16(v1[0], v1[1]); w.w = cvt_pk_bf16(v1[2], v1[3]);
                        st16_wt<0>(mo, (unsigned)off * 2u, w); } }
            asm volatile("" ::: "memory"); }
    }
};
struct EpiF {
    unsigned char* fptr; size_t fblk;
    __device__ __forceinline__ void operator()(const f32x4 (&acc)[2][2][4][2], const Unit& u, int wr, int wc, int lane_) const {
        const int ln = launder_v(lane_), fr = ln & 15, fq = ln >> 4;
        const int lr0 = wr * 64 + fr, col0 = u.pn * BM + wc * 32 + 8 * fq;
        bf16_t* fo = (bf16_t*)(fptr + (size_t)u.pm * fblk);
#pragma unroll
        for (int ai = 0; ai < 2; ++ai)
#pragma unroll
            for (int m = 0; m < 4; ++m) { const unsigned vo = (unsigned)((lr0 + ai * HALF + m * 16) * D + col0) * 2u;
#pragma unroll
                for (int bj = 0; bj < 2; ++bj) { const f32x4 v0 = acc[ai][bj][m][0], v1 = acc[ai][bj][m][1];
                    u32x4 w; w.x = cvt_pk_bf16(v0[0], v0[1]); w.y = cvt_pk_bf16(v0[2], v0[3]); w.z = cvt_pk_bf16(v1[0], v1[1]); w.w = cvt_pk_bf16(v1[2], v1[3]);
                    if (bj == 0) st16_wt<0>(fo, vo, w); else st16_wt<256>(fo, vo, w); }
                asm volatile("" ::: "memory"); }
    }
};
struct EpiUp {
    unsigned char* ws;
    __device__ __forceinline__ void operator()(const f32x4 (&acc)[2][2][4][2], const Unit& u, int wr, int wc, int lane_) const {
        const int ln = launder_v(lane_), fr = ln & 15, fq = ln >> 4;
        const int lr0 = wr * 64 + fr, col0 = u.pn * BM + wc * 32 + 8 * fq;
        bf16_t* ro = (bf16_t*)(ws + WS_BIG + (size_t)u.pm * BIG_BLK); const float* rstd = (const float*)(ws + WS_RSB) + u.pm * BM;
        float rsv[2][4];
#pragma unroll
        for (int ai = 0; ai < 2; ++ai)
#pragma unroll
            for (int m = 0; m < 4; ++m) rsv[ai][m] = rstd[lr0 + ai * HALF + m * 16];
#pragma unroll
        for (int ai = 0; ai < 2; ++ai)
#pragma unroll
            for (int m = 0; m < 4; ++m) { const int lr = lr0 + ai * HALF + m * 16; const float rs = rsv[ai][m]; const unsigned vo = (unsigned)(lr * DFF + col0) * 2u;
#pragma unroll
                for (int bj = 0; bj < 2; ++bj) { float v[8];
#pragma unroll
                    for (int j = 0; j < 4; ++j) { v[j] = acc[ai][bj][m][0][j] * rs; v[4 + j] = acc[ai][bj][m][1][j] * rs; }
#pragma unroll
                    for (int j = 0; j < 8; ++j) { v[j] = fmaxf(v[j], 0.f); v[j] = v[j] * v[j]; }
                    u32x4 w; w.x = cvt_pk_bf16(v[0], v[1]); w.y = cvt_pk_bf16(v[2], v[3]); w.z = cvt_pk_bf16(v[4], v[5]); w.w = cvt_pk_bf16(v[6], v[7]);
                    if (bj == 0) st16_wt<0>(ro, vo, w); else st16_wt<256>(ro, vo, w); }
                asm volatile("" ::: "memory"); }
    }
};

__device__ __forceinline__ void transpose_item(const float* W, int K, int N, bf16_t* WT, int ldt, int coff, const float* sc, LAS float* scr, int item, int lane) {
    const int nblk = N / 32, kb = item / nblk, nb = item % nblk, k0 = 64 * kb, n0 = 32 * nb;
    float tv[32];
#pragma unroll
    for (int i = 0; i < 32; ++i) { const int kk = 2 * i + (lane >> 5); tv[i] = W[(size_t)(k0 + kk) * N + n0 + (lane & 31)]; }
#pragma unroll
    for (int i = 0; i < 32; ++i) { const int kk = 2 * i + (lane >> 5); float v = tv[i]; if (sc) v *= sc[k0 + kk]; scr[kk * 33 + (lane & 31)] = v; }
    asm volatile("s_waitcnt lgkmcnt(0)" ::: "memory");
    const int c = lane & 7;
#pragma unroll
    for (int j = 0; j < 4; ++j) { const int n = (lane >> 3) + 8 * j; const LAS float* s = scr + (8 * c) * 33 + n;
        u32x4 o; o.x = cvt_pk_bf16(s[0 * 33], s[1 * 33]); o.y = cvt_pk_bf16(s[2 * 33], s[3 * 33]); o.z = cvt_pk_bf16(s[4 * 33], s[5 * 33]); o.w = cvt_pk_bf16(s[6 * 33], s[7 * 33]);
        st16_wt<0>(WT, (unsigned)((n0 + n) * ldt + coff + k0 + 8 * c) * 2u, o); }
    asm volatile("s_waitcnt lgkmcnt(0)" ::: "memory");
}
struct Params { const float* in[19]; float* out; unsigned char* ws; int ph_lo, ph_hi; };
typedef const __attribute__((address_space(4))) Params Ptrs;
__device__ __forceinline__ Ptrs* kargs() { Ptrs* p = (Ptrs*)__builtin_amdgcn_kernarg_segment_ptr(); asm volatile("" : "+s"(p)); return p; }

__device__ __forceinline__ void prep_layer(Ptrs& P, int l, LAS unsigned char* lds, int wave, int lane, int wg, int nwg) {
    LAS float* scr = (LAS float*)(lds + wave * 8704);
    const int gw = wg * 8 + wave, NGW = nwg * 8;
    unsigned char* wb = P.ws + (size_t)(l & 1) * WBLK;
    const float* w_in = P.in[3] + (size_t)l * D * DIN; const float* w_pg = P.in[4] + (size_t)l * 4 * 128 * 128; const float* pscale = P.in[5] + (size_t)l * WA;
    const float* w_sp = P.in[6] + (size_t)l * 8 * 128 * 128; const float* w_ba = P.in[10] + (size_t)l * WA * D; const float* w_bb = P.in[11] + (size_t)l * D * D;
    const float* w_out = P.in[12] + (size_t)l * D * D; const float* w_up = P.in[13] + (size_t)l * D * DFF; const float* w_dn = P.in[14] + (size_t)l * DFF * D;
    const float* g1 = P.in[15] + (size_t)l * D; const float* g3 = P.in[17] + (size_t)l * D;
    constexpr int I_IN = (D / 64) * (DIN / 32), I_BB = (D / 64) * (D / 32), I_OUT = I_BB, I_UP = (D / 64) * (DFF / 32), I_DN = (DFF / 64) * (D / 32), I_FOLD = 4 * 32 * 16, I_SP = 256;
    constexpr int NITEMS = I_IN + I_BB + I_OUT + I_UP + I_DN + I_FOLD + I_SP;
    for (int it = gw; it < NITEMS; it += NGW) {
        int r = it;
        if (r < I_IN) { transpose_item(w_in, D, DIN, (bf16_t*)(wb + WOFF_IN), D, 0, g1, scr, r, lane); continue; } r -= I_IN;
        if (r < I_BB) { transpose_item(w_bb, D, D, (bf16_t*)(wb + WOFF_AB), KAB, 512, nullptr, scr, r, lane); continue; } r -= I_BB;
        if (r < I_OUT) { transpose_item(w_out, D, D, (bf16_t*)(wb + WOFF_OUT), D, 0, nullptr, scr, r, lane); continue; } r -= I_OUT;
        if (r < I_UP) { transpose_item(w_up, D, DFF, (bf16_t*)(wb + WOFF_UP), D, 0, g3, scr, r, lane); continue; } r -= I_UP;
        if (r < I_DN) { transpose_item(w_dn, DFF, D, (bf16_t*)(wb + WOFF_DN), DFF, 0, nullptr, scr, r, lane); continue; } r -= I_DN;
        if (r < I_FOLD) {
            const int g = r >> 9, cb = (r >> 4) & 31, nb = r & 15, n = nb * 64 + lane;
            float acc[4] = {0.f, 0.f, 0.f, 0.f};
            const float* pg = w_pg + ((size_t)g * 128 + cb * 4) * 128;
            for (int d0 = 0; d0 < 128; d0 += 16) { float wv[16];
#pragma unroll
                for (int q = 0; q < 16; ++q) wv[q] = w_ba[(size_t)(g * 128 + d0 + q) * D + n];
#pragma unroll
                for (int q = 0; q < 16; ++q) { const float x = wv[q] * pscale[g * 128 + d0 + q];
#pragma unroll
                    for (int j = 0; j < 4; ++j) acc[j] += pg[j * 128 + d0 + q] * x; } }
            u32x2 o; o.x = cvt_pk_bf16(acc[0], acc[1]); o.y = cvt_pk_bf16(acc[2], acc[3]);
            st8b_wt(wb + WOFF_AB, (unsigned)(n * KAB + g * 128 + cb * 4) * 2u, o); continue; } r -= I_FOLD;
        {
            const int e0 = r * 512 + lane * 8, s0 = e0 & 127, t = (e0 >> 7) & 127;
            const f32x4 x0 = *(const f32x4*)(w_sp + e0), x1 = *(const f32x4*)(w_sp + e0 + 4); float v[8] = {x0[0], x0[1], x0[2], x0[3], x1[0], x1[1], x1[2], x1[3]};
#pragma unroll
            for (int j = 0; j < 8; ++j) v[j] = (s0 + j <= t) ? v[j] : 0.f;
            u32x4 o; o.x = cvt_pk_bf16(v[0], v[1]); o.y = cvt_pk_bf16(v[2], v[3]); o.z = cvt_pk_bf16(v[4], v[5]); o.w = cvt_pk_bf16(v[6], v[7]);
            st16_wt<0>(wb + WOFF_SP, (unsigned)e0 * 2u, o); }
    }
}

__device__ __forceinline__ void phase_r0(Ptrs& P, int tid, int wave, int lane) {
    bf16_t* xb = (bf16_t*)(P.ws + WS_XB); float* rsa = (float*)(P.ws + WS_RSA);
    for (int it = blockIdx.x; it < NPANEL * 8; it += gridDim.x) {
        for (int i = 0; i < 4; ++i) { const int m = it * 32 + wave * 4 + i;
            const float* src = m < MP ? P.in[0] + (size_t)m * D : P.in[1] + (size_t)(m - MP) * D;
            f32x4 v[4]; float ss = 0.f;
#pragma unroll
            for (int j = 0; j < 4; ++j) { v[j] = *(const f32x4*)(src + 256 * j + 4 * lane); ss += (v[j][0] * v[j][0] + v[j][1] * v[j][1]) + (v[j][2] * v[j][2] + v[j][3] * v[j][3]); }
            ss = wave_sum(ss, lane);
#pragma unroll
            for (int j = 0; j < 4; ++j) { u32x2 w; w.x = cvt_pk_bf16(v[j][0], v[j][1]); w.y = cvt_pk_bf16(v[j][2], v[j][3]); st8b_wt(xb, (unsigned)(m * D + 256 * j + 4 * lane) * 2u, w); }
            if (lane == 0) __hip_atomic_store((unsigned*)(rsa + m), __float_as_uint(1.0f / sqrtf(ss * (1.0f / D) + EPS)), __ATOMIC_RELAXED, __HIP_MEMORY_SCOPE_AGENT); }
        dep_done_wt(cnt_ptr(P.ws, 0, C_X) + 64 * (it >> 3), tid, 2u);
    }
}
__device__ __forceinline__ void phase_res(Ptrs& P, const float* g, float* rs_out, const unsigned char* fptr, const size_t fblk, const unsigned* cwait, unsigned* cdone, unsigned* tmo, const bool final_out, int tid, int wave, int lane) {
    float* yo = P.out + OUT_X; bf16_t* xb = (bf16_t*)(P.ws + WS_XB);
    f32x4 gv[4];
#pragma unroll
    for (int j = 0; j < 4; ++j) gv[j] = *(const f32x4*)(g + 256 * j + 4 * lane);
    for (int it = blockIdx.x; it < NPANEL * 8; it += gridDim.x) {
        const int pm = it >> 3;
        dep_wait(cwait + 64 * pm, 32u, tmo, tid);
        const bf16_t* fb = (const bf16_t*)(fptr + (size_t)pm * fblk);
        for (int i = 0; i < 4; ++i) { const int lr = (it & 7) * 32 + wave * 4 + i, m = pm * BM + lr;
            f32x4 fv[4], xv[4]; float ss = 0.f;
#pragma unroll
            for (int j = 0; j < 4; ++j) { const u32x2 fw = *(const u32x2*)(fb + (size_t)lr * D + 256 * j + 4 * lane); fv[j] = (f32x4){bf_lo(fw.x), bf_hi(fw.x), bf_lo(fw.y), bf_hi(fw.y)};
                const u32x2 xw = *(const u32x2*)(xb + (size_t)m * D + 256 * j + 4 * lane); xv[j] = (f32x4){bf_lo(xw.x), bf_hi(xw.x), bf_lo(xw.y), bf_hi(xw.y)};
                ss += (fv[j][0] * fv[j][0] + fv[j][1] * fv[j][1]) + (fv[j][2] * fv[j][2] + fv[j][3] * fv[j][3]); }
            const float c = 1.0f / sqrtf(wave_sum(ss, lane) * (1.0f / D) + EPS); float s2 = 0.f;
#pragma unroll
            for (int j = 0; j < 4; ++j) { xv[j] = xv[j] + fv[j] * c * gv[j]; s2 += (xv[j][0] * xv[j][0] + xv[j][1] * xv[j][1]) + (xv[j][2] * xv[j][2] + xv[j][3] * xv[j][3]); }
            if (final_out) {
#pragma unroll
                for (int j = 0; j < 4; ++j) *(f32x4*)(yo + (size_t)m * D + 256 * j + 4 * lane) = xv[j];
            } else {
                s2 = wave_sum(s2, lane);
#pragma unroll
                for (int j = 0; j < 4; ++j) { u32x2 w; w.x = cvt_pk_bf16(xv[j][0], xv[j][1]); w.y = cvt_pk_bf16(xv[j][2], xv[j][3]); st8b_wt(xb, (unsigned)(m * D + 256 * j + 4 * lane) * 2u, w); }
                if (lane == 0) __hip_atomic_store((unsigned*)(rs_out + m), __float_as_uint(1.0f / sqrtf(s2 * (1.0f / D) + EPS)), __ATOMIC_RELAXED, __HIP_MEMORY_SCOPE_AGENT); } }
        if (cdone) dep_done_wt(cdone + 64 * pm, tid, 2u);
    }
}

constexpr int VT_LD = 136;
__device__ __forceinline__ void sgu_item(Ptrs& P, int l, int item, LAS unsigned char* lds, int tid, int wave, int lane) {
    const int chunk = item >> 3, h = item & 7, row0 = chunk * 128, pm = chunk >> 1, lr0 = (chunk & 1) * 128; const bool is_sample = chunk >= 128;
    const int fr = lane & 15, fq = lane >> 4;
    LAS float* st = (LAS float*)lds;
    LAS bf16_t* VT = (LAS bf16_t*)(lds + 1024);
    const float* lnpart = (const float*)(P.ws + WS_LNP);
    const bf16_t* ub = (const bf16_t*)(P.ws + WS_BIG + (size_t)pm * BIG_BLK) + (size_t)lr0 * D; const bf16_t* gvb = ub + SEG_B / 2;
    const bf16_t* wsp = (const bf16_t*)(P.ws + (size_t)(l & 1) * WBLK + WOFF_SP);
    bf16_t* dyb = (bf16_t*)(P.ws + WS_DY + (size_t)pm * DY_BLK) + (size_t)lr0 * KAB;
    const float* lng = P.in[8] + (size_t)l * D; const float* lnb = P.in[9] + (size_t)l * D; const float* bsp = P.in[7] + (size_t)l * 8 * 128;
    const int w = wave, k1 = w >> 1, k0 = is_sample ? k1 : 0;
    bf16x8 af[4];
#pragma unroll
    for (int k = 0; k < 4; ++k) { af[k] = (bf16x8){0, 0, 0, 0, 0, 0, 0, 0};
        if (!is_sample) { if (k <= k1) af[k] = *(const bf16x8*)(wsp + ((size_t)(h * 128 + 16 * w + fr)) * 128 + 32 * k + 8 * fq); }
        else if (k == k1 && fq == 2 * (w & 1) + (fr >> 3)) af[k] = *(const bf16x8*)(wsp + ((size_t)(h * 128 + (fr & 7))) * 128); }
    const int tl = 16 * w + fr; const float bias = bsp[h * 128 + (is_sample ? (fr & 7) : tl)];
    u32x2 uu[8];
#pragma unroll
    for (int n = 0; n < 8; ++n) uu[n] = *(const u32x2*)(ub + (size_t)tl * D + h * 128 + 16 * n + 4 * fq);
    u32x4 gr0[2], gr1[2]; f32x4 lga[2], lgb[2], lba[2], lbb[2];
#pragma unroll
    for (int it = 0; it < 2; ++it) { const int idx = tid + it * 512, p = idx & 63, cg8 = idx >> 6, s = 2 * p, col = h * 128 + cg8 * 8;
        gr0[it] = *(const u32x4*)(gvb + (size_t)s * D + col); gr1[it] = *(const u32x4*)(gvb + (size_t)(s + 1) * D + col);
        lga[it] = *(const f32x4*)(lng + col); lgb[it] = *(const f32x4*)(lng + col + 4); lba[it] = *(const f32x4*)(lnb + col); lbb[it] = *(const f32x4*)(lnb + col + 4); }
    if (tid < 128) { const float* p = lnpart + (size_t)(row0 + tid) * 32; float s1 = 0.f, s2 = 0.f;
#pragma unroll
        for (int j = 0; j < 8; ++j) { const f32x4 q = *(const f32x4*)(p + 4 * j); s1 += q[0] + q[2]; s2 += q[1] + q[3]; }
        const float mean = s1 * (1.0f / D), var = fmaxf(s2 * (1.0f / D) - mean * mean, 0.f);
        st[2 * tid] = mean; st[2 * tid + 1] = 1.0f / sqrtf(var + EPS); }
    __syncthreads();
#pragma unroll
    for (int it = 0; it < 2; ++it) { const int idx = tid + it * 512, p = idx & 63, cg8 = idx >> 6, s = 2 * p, col = h * 128 + cg8 * 8;
        const u32x4 r0 = gr0[it], r1 = gr1[it];
        const f32x4 ga = lga[it], gb = lgb[it], ba = lba[it], bb = lbb[it];
        const float m0 = st[2 * s], q0 = st[2 * s + 1], m1 = st[2 * s + 2], q1 = st[2 * s + 3];
        float a0[8] = {bf_lo(r0.x), bf_hi(r0.x), bf_lo(r0.y), bf_hi(r0.y), bf_lo(r0.z), bf_hi(r0.z), bf_lo(r0.w), bf_hi(r0.w)};
        float a1[8] = {bf_lo(r1.x), bf_hi(r1.x), bf_lo(r1.y), bf_hi(r1.y), bf_lo(r1.z), bf_hi(r1.z), bf_lo(r1.w), bf_hi(r1.w)};
        const float gg[8] = {ga[0], ga[1], ga[2], ga[3], gb[0], gb[1], gb[2], gb[3]}, bq[8] = {ba[0], ba[1], ba[2], ba[3], bb[0], bb[1], bb[2], bb[3]};
#pragma unroll
        for (int j = 0; j < 8; ++j) { a0[j] = (a0[j] - m0) * q0 * gg[j] + bq[j]; a1[j] = (a1[j] - m1) * q1 * gg[j] + bq[j]; }
        if (is_sample) { float* vo = P.out + OUT_VS + ((size_t)l * MS + (row0 - MP) + s) * D + col;
            *(f32x4*)(vo) = (f32x4){a0[0], a0[1], a0[2], a0[3]}; *(f32x4*)(vo + 4) = (f32x4){a0[4], a0[5], a0[6], a0[7]};
            *(f32x4*)(vo + D) = (f32x4){a1[0], a1[1], a1[2], a1[3]}; *(f32x4*)(vo + D + 4) = (f32x4){a1[4], a1[5], a1[6], a1[7]}; }
#pragma unroll
        for (int j = 0; j < 8; ++j) *(LAS unsigned*)(VT + (cg8 * 8 + j) * VT_LD + s) = cvt_pk_bf16(a0[j], a1[j]);
    }
    __syncthreads();
    f32x4 acc[8];
#pragma unroll
    for (int n = 0; n < 8; ++n) acc[n] = (f32x4){0.f, 0.f, 0.f, 0.f};
#pragma unroll
    for (int k = 0; k < 4; ++k) { if (k >= k0 && k <= k1) {
#pragma unroll
        for (int n = 0; n < 8; ++n) { const bf16x8 bfr = *(const LAS bf16x8*)(VT + (16 * n + fr) * VT_LD + 32 * k + 8 * fq);
            acc[n] = __builtin_amdgcn_mfma_f32_16x16x32_bf16(bfr, af[k], acc[n], 0, 0, 0); } } }
#pragma unroll
    for (int n = 0; n < 8; ++n) { const int col = h * 128 + 16 * n + 4 * fq;
        const float y0 = bf_lo(uu[n].x) * (acc[n][0] + bias), y1 = bf_hi(uu[n].x) * (acc[n][1] + bias), y2 = bf_lo(uu[n].y) * (acc[n][2] + bias), y3 = bf_hi(uu[n].y) * (acc[n][3] + bias);
        u32x2 o; o.x = cvt_pk_bf16(y0, y1); o.y = cvt_pk_bf16(y2, y3); st8b_wt(dyb, (unsigned)(tl * KAB + 512 + col) * 2u, o); }
}
__device__ __forceinline__ f32x4 ld_a(const unsigned char* ws, int gr, int ch) {
    const u32x2 w = *(const u32x2*)((const bf16_t*)(ws + WS_AF + (size_t)(gr >> 8) * AF_BLK) + (size_t)(gr & 255) * WA + ch);
    return (f32x4){bf_lo(w.x), bf_hi(w.x), bf_lo(w.y), bf_hi(w.y)};
}
template <int W>
__device__ __forceinline__ void pool_w(Ptrs& P, int l, int chunk, int g, int tid) {
    const int cq = tid & 31, rs = tid >> 5, ch = g * 128 + cq * 4;
    const unsigned char* ws = P.ws;
    f32x4 rows[W + 7];
    if (chunk < 128) {
        const int rb = chunk * 128, t0 = (chunk & 15) * 128, tl0 = rs * 8;
        bf16_t* dyb = (bf16_t*)(P.ws + WS_DY + (size_t)(chunk >> 1) * DY_BLK) + (size_t)((chunk & 1) * 128) * KAB;
#pragma unroll
        for (int k = 0; k < W + 7; ++k) { const int tl = tl0 - (W - 1) + k; rows[k] = (t0 + tl >= 0) ? ld_a(ws, rb + tl, ch) : (f32x4){0.f, 0.f, 0.f, 0.f}; }
        f32x4 S = (f32x4){0.f, 0.f, 0.f, 0.f};
#pragma unroll
        for (int k = 0; k < W - 1; ++k) S = S + rows[k];
#pragma unroll
        for (int i = 0; i < 8; ++i) { const int tl = tl0 + i, pos = t0 + tl; const f32x4 cur = rows[W - 1 + i];
            S = S + cur; const float inv = 1.0f / (float)(pos + 1 < W ? pos + 1 : W); const f32x4 d = S * inv - cur;
            u32x2 o; o.x = cvt_pk_bf16(d[0], d[1]); o.y = cvt_pk_bf16(d[2], d[3]); st8b_wt(dyb, (unsigned)(tl * KAB + ch) * 2u, o);
            if ((chunk & 15) == 15 && tl >= 113) *(f32x4*)(P.out + OUT_PP + (((size_t)l * 8 + (chunk >> 4)) * 15 + (tl - 113)) * WA + ch) = cur;
            S = S - rows[i]; }
    } else {
        const int seq = (chunk - 128) * 16 + rs; const float* sp = P.in[2] + ((size_t)l * 128 + seq) * 15 * WA + ch; const int gr0 = MP + seq * 8;
        bf16_t* dyb = (bf16_t*)(P.ws + WS_DY + (size_t)(chunk >> 1) * DY_BLK) + (size_t)((chunk & 1) * 128) * KAB;
        float* po = P.out + OUT_PS + ((size_t)l * 128 + seq) * 15 * WA + ch;
#pragma unroll
        for (int k = 0; k < W + 7; ++k) { const int e = 15 - (W - 1) + k; rows[k] = e < 15 ? *(const f32x4*)(sp + (size_t)e * WA) : ld_a(ws, gr0 + e - 15, ch); }
#pragma unroll
        for (int i = 0; i < 7; ++i) *(f32x4*)(po + (size_t)i * WA) = *(const f32x4*)(sp + (size_t)(8 + i) * WA);
        f32x4 S = (f32x4){0.f, 0.f, 0.f, 0.f};
#pragma unroll
        for (int k = 0; k < W - 1; ++k) S = S + rows[k];
#pragma unroll
        for (int i = 0; i < 8; ++i) { const f32x4 cur = rows[W - 1 + i];
            S = S + cur; const f32x4 d = S * (1.0f / (float)W) - cur;
            u32x2 o; o.x = cvt_pk_bf16(d[0], d[1]); o.y = cvt_pk_bf16(d[2], d[3]); st8b_wt(dyb, (unsigned)((rs * 8 + i) * KAB + ch) * 2u, o);
            *(f32x4*)(po + (size_t)(7 + i) * WA) = cur;
            S = S - rows[i]; }
    }
}
__device__ __forceinline__ void pool_item(Ptrs& P, int l, int item, int tid) {
    const int chunk = item >> 2, g = item & 3;
    if (g == 0) pool_w<2>(P, l, chunk, g, tid); else if (g == 1) pool_w<4>(P, l, chunk, g, tid); else if (g == 2) pool_w<8>(P, l, chunk, g, tid); else pool_w<16>(P, l, chunk, g, tid);
}
__device__ __forceinline__ void phase_mix(Ptrs& P, int l, LAS unsigned char* lds, unsigned* tmo, int tid, int wave, int lane) {
    const unsigned* cw = cnt_ptr(P.ws, l, C_G1);
    for (int it = blockIdx.x; it < NPANEL * 12; it += gridDim.x) {
        const int pm = it / 12, r = it - pm * 12;
        if (r < 8) { const int chunk = pm * 2 + (r >> 2), h0 = (r & 3) * 2;
            dep_wait(cw + 64 * pm, 80u, tmo, tid);
            sgu_item(P, l, chunk * 8 + h0, lds, tid, wave, lane); __syncthreads(); sgu_item(P, l, chunk * 8 + h0 + 1, lds, tid, wave, lane);
        } else { const int chunk = pm * 2 + ((r - 8) >> 1), g0 = ((r - 8) & 1) * 2;
            if ((chunk & 1) == 0 && chunk < 128 && (chunk & 15) != 0) dep_wait2(cw + 64 * pm, cw + 64 * (pm - 1), 80u, tmo, tid); else dep_wait(cw + 64 * pm, 80u, tmo, tid);
            pool_item(P, l, chunk * 4 + g0, tid); pool_item(P, l, chunk * 4 + g0 + 1, tid); }
        dep_done_wt(cnt_ptr(P.ws, l, C_MIX) + 64 * pm, tid, 2u);
        __syncthreads();
    }
}
}

__global__ void __launch_bounds__(512, 2) mk_fwd(Params prm) {
    extern __shared__ __attribute__((aligned(16))) unsigned char lds_raw[];
    LAS unsigned char* lds = (LAS unsigned char*)lds_raw;
    cg::grid_group grid = cg::this_grid();
    volatile LAS unsigned* bst = (volatile LAS unsigned*)(lds + 131072 + 512);
    if (threadIdx.x < 2) bst[threadIdx.x] = 0u;
    __syncthreads();
    (void)xcd_barrier_post((unsigned*)(prm.ws + WS_BAR), bst);
    if (prm.ph_hi < 0) grid.sync();
    constexpr int nM = M / BM;
    const int wave = __builtin_amdgcn_readfirstlane(threadIdx.x >> 6);
    constexpr size_t TS1K = (size_t)BM * D * 2;
    {
        const int lane = launder_v(lane_id()), tid = wave * 64 + lane;
        Ptrs& P = *kargs();
        phase_r0(P, tid, wave, lane); prep_layer(P, 0, lds, wave, lane, blockIdx.x, gridDim.x);
        xcd_barrier((unsigned*)(P.ws + WS_BAR), (volatile LAS unsigned*)(lds + 131072 + 512), tid);
    }
    for (int l = 0; l < DEPTH; ++l) {
        for (int s = 0; s < 9; ++s) {
            const int lane = launder_v(lane_id()), tid = wave * 64 + lane;
            Ptrs& P = *kargs(); unsigned char* ws = P.ws; unsigned char* wb = ws + (size_t)(l & 1) * WBLK;
            unsigned* tmo = (unsigned*)(ws + WS_BAR) + XB_TMO;
            const unsigned* prepc = cnt_ptr(ws, 5, 0) + 64 * l;
            Dep dp{cnt_ptr(ws, l, 0), tmo, l >= 1 ? cnt_ptr(ws, l - 1, C_MIX) : prepc, prepc, l >= 1 ? (gridDim.x == 256 ? 208u : gridDim.x) : 0u};
            if (s == 0 && ((MK_SMASK >> 0) & 1)) {
                EpiIn E{ws};
                gemm_phase<0, 6, C_X, 16, C_G1, EpiIn>(wave, lds, (const bf16_t*)(ws + WS_XB), TS1K, (const bf16_t*)(wb + WOFF_IN), D, nM, DIN / BM, E, dp);
            } else if (s == 2 && ((MK_SMASK >> 2) & 1)) {
                phase_mix(P, l, lds, tmo, tid, wave, lane);
            } else if (s == 3 && ((MK_SMASK >> 3) & 1)) {
                EpiAB E{ws, (unsigned char*)P.out + OUT_MSCR};
                gemm_phase<1, 3, C_MIX, 24, C_G2, EpiAB>(wave, lds, (const bf16_t*)(ws + WS_DY), DY_BLK, (const bf16_t*)(wb + WOFF_AB), KAB, nM, D / BM, E, dp);
            } else if (s == 4 && ((MK_SMASK >> 4) & 1)) {
                EpiF E{(unsigned char*)P.out, AF_BLK};
                gemm_phase<0, 4, C_G2, 32, C_G3, EpiF>(wave, lds, (const bf16_t*)((unsigned char*)P.out + OUT_MSCR), TS1K, (const bf16_t*)(wb + WOFF_OUT), D, nM, D / BM, E, dp);
                if (l + 1 < DEPTH) {
                    const int c = blockIdx.x, v = (c & 7) * 32 + (c >> 3), h = v >> 4, p = v - h - 1; const bool sub = gridDim.x == 256;
                    if (!sub || ((v & 15) != 0 && p >= 32)) {
                        if (l >= 1) dep_wait_many(cnt_ptr(ws, l - 1, C_G5), NPANEL, 32u, tmo, tid, [](int i) { return i; });
                        if (sub) prep_layer(P, l + 1, lds, wave, lane, p - 32, 208); else prep_layer(P, l + 1, lds, wave, lane, blockIdx.x, gridDim.x);
                        dep_done_wt(cnt_ptr(ws, 5, 0) + 64 * (l + 1), tid); }
                }
            } else if (s == 5 && ((MK_SMASK >> 5) & 1)) {
                phase_res(P, P.in[16] + (size_t)l * D, (float*)(ws + WS_RSB), (const unsigned char*)P.out, AF_BLK, cnt_ptr(ws, l, C_G3), cnt_ptr(ws, l, C_R1), tmo, false, tid, wave, lane);
                if (l + 1 == DEPTH) xcd_barrier((unsigned*)(ws + WS_BAR), (volatile LAS unsigned*)(lds + 131072 + 512), tid);
            } else if (s == 6 && ((MK_SMASK >> 6) & 1)) {
                EpiUp E{ws};
                gemm_phase<0, 1, C_R1, 16, C_G4, EpiUp>(wave, lds, (const bf16_t*)(ws + WS_XB), TS1K, (const bf16_t*)(wb + WOFF_UP), D, nM, DFF / BM, E, dp);
            } else if (s == 7 && ((MK_SMASK >> 7) & 1)) {
                EpiF E{ws + WS_DY, DY_BLK};
                gemm_phase<0, 2, C_G4, 128, C_G5, EpiF>(wave, lds, (const bf16_t*)(ws + WS_BIG), BIG_BLK, (const bf16_t*)(wb + WOFF_DN), DFF, nM, D / BM, E, dp);
            } else if (s == 8 && ((MK_SMASK >> 8) & 1)) {
                phase_res(P, P.in[18] + (size_t)l * D, (float*)(ws + WS_RSA), ws + WS_DY, DY_BLK, cnt_ptr(ws, l, C_G5), l + 1 < DEPTH ? cnt_ptr(ws, l + 1, C_X) : nullptr, tmo, l + 1 == DEPTH, tid, wave, lane);
            }
            __syncthreads();
        }
    }
}

extern "C" void kernel_launch(void* const* d_in, const int* in_sizes, int n_in, void* d_out, int out_size, void* d_ws, size_t ws_size, hipStream_t stream) {
    static int grid = 0;
    if (grid == 0) {
        if (n_in != 19 || in_sizes[0] != MP * D || in_sizes[1] != MS * D || ws_size < WS_END || (size_t)out_size != OUT_VS + (size_t)DEPTH * MS * D) {
            fprintf(stderr, "kernel_launch: unexpected shapes / workspace (n_in %d, ws %zu, out %d); nothing launched\n", n_in, ws_size, out_size); grid = -1; return; }
        int dev = 0, cus = 0, per_cu = 0;
        if (hipGetDevice(&dev) != hipSuccess || hipDeviceGetAttribute(&cus, hipDeviceAttributeMultiprocessorCount, dev) != hipSuccess) { grid = -1; return; }
        if (hipFuncSetAttribute((const void*)mk_fwd, hipFuncAttributeMaxDynamicSharedMemorySize, LDS_BYTES) != hipSuccess) { fprintf(stderr, "kernel_launch: hipFuncSetAttribute failed\n"); grid = -1; return; }
        if (hipOccupancyMaxActiveBlocksPerMultiprocessor(&per_cu, (const void*)mk_fwd, 512, LDS_BYTES) != hipSuccess || per_cu < 1) { fprintf(stderr, "kernel_launch: occupancy query says %d\n", per_cu); per_cu = 1; }
        (void)hipGetLastError();
        grid = cus * 1;
    }
    if (grid < 0) return;
    if (hipMemsetAsync((char*)d_ws + WS_BAR, 0, CTL_BYTES, stream) != hipSuccess) { fprintf(stderr, "kernel_launch: memset failed\n"); return; }
    Params a{};
    for (int i = 0; i < 19; ++i) a.in[i] = (const float*)d_in[i];
    a.out = (float*)d_out; a.ws = (unsigned char*)d_ws;
    a.ph_lo = 0; a.ph_hi = 1;
    void* args[] = {&a};
    hipError_t e = hipLaunchCooperativeKernel((const void*)mk_fwd, dim3(grid), dim3(512), args, LDS_BYTES, stream);
    if (e != hipSuccess) fprintf(stderr, "cooperative launch failed: %s (grid %d)\n", hipGetErrorString(e), grid);
}
```

```cpp
#include <hip/hip_runtime.h>
#include <hip/hip_cooperative_groups.h>
#include <cstdio>
namespace cg = cooperative_groups;

#ifndef MK_NOHOOK
#define MK_NOHOOK 0
#endif
#ifndef MK_SMASK
#define MK_SMASK 511
#endif
#define LAS __attribute__((address_space(3)))
typedef unsigned short bf16_t;
typedef short bf16x8 __attribute__((ext_vector_type(8)));
typedef float f32x4 __attribute__((ext_vector_type(4)));
typedef float f32x2 __attribute__((ext_vector_type(2)));
typedef unsigned u32x4 __attribute__((ext_vector_type(4)));
typedef unsigned u32x2 __attribute__((ext_vector_type(2)));

namespace {
constexpr int MP = 16384, MS = 1024, M = MP + MS;
constexpr int D = 1024, DIN = 4608, DFF = 4096, DEPTH = 4, WA = 512;
constexpr int KAB = 1536;
constexpr float EPS = 1e-6f;
constexpr size_t MiB = 1u << 20;
constexpr size_t WBLK = 31 * MiB;
constexpr size_t WOFF_IN = 0, WOFF_AB = 9 * MiB, WOFF_OUT = 12 * MiB, WOFF_UP = 14 * MiB, WOFF_DN = 22 * MiB, WOFF_SP = 30 * MiB;
constexpr size_t WS_XB = 62 * MiB;
constexpr size_t OUT_MSCR = 34 * MiB;
constexpr size_t WS_BIG = 96 * MiB, BIG_BLK = 2 * MiB;
constexpr size_t SEG_B = 512 * 1024;
constexpr size_t WS_AF = 232 * MiB, AF_BLK = 512 * 1024;
constexpr size_t WS_DY = 266 * MiB, DY_BLK = 768 * 1024;
constexpr size_t WS_RSA = 317 * MiB, WS_RSB = 317 * MiB + 128 * 1024, WS_LNP = 318 * MiB;
constexpr size_t WS_BAR = 321 * MiB, BAR_CNT_OFF = 65536, CTL_BYTES = 1 * MiB, WS_END = 322 * MiB;
enum { C_X = 0, C_G1 = 1, C_MIX = 2, C_G2 = 3, C_G3 = 4, C_R1 = 5, C_G4 = 6, C_G5 = 7 };
constexpr int NPANEL = 68;
constexpr size_t OUT_X = 0, OUT_PP = (size_t)M * D, OUT_PS = OUT_PP + (size_t)DEPTH * 8 * 15 * WA, OUT_VS = OUT_PS + (size_t)DEPTH * 128 * 15 * WA;
constexpr int LDS_BYTES = 147456;

__device__ __forceinline__ unsigned cvt_pk_bf16(float lo, float hi) { unsigned r; asm volatile("v_cvt_pk_bf16_f32 %0, %1, %2" : "=v"(r) : "v"(lo), "v"(hi)); return r; }
template <int OFF> __device__ __forceinline__ void st16_wt(const void* sbase, unsigned voff, u32x4 v) {
    const __amdgpu_buffer_rsrc_t r = __builtin_amdgcn_make_buffer_rsrc((void*)sbase, 0, 0x40000000, 0x00020000); __builtin_amdgcn_raw_buffer_store_b128(v, r, voff + OFF, 0, 16); }
__device__ __forceinline__ void st8b_wt(const void* sbase, unsigned voff, u32x2 v) {
    const __amdgpu_buffer_rsrc_t r = __builtin_amdgcn_make_buffer_rsrc((void*)sbase, 0, 0x40000000, 0x00020000); __builtin_amdgcn_raw_buffer_store_b64(v, r, voff, 0, 16); }
__device__ __forceinline__ void st8_wt(void* p, f32x2 v) { asm volatile("global_store_dwordx2 %0, %1, off sc1" :: "v"(p), "v"(v) : "memory"); }
__device__ __forceinline__ float bf_lo(unsigned w) { return __uint_as_float(w << 16); }
__device__ __forceinline__ float bf_hi(unsigned w) { return __uint_as_float(w & 0xffff0000u); }
__device__ __forceinline__ float sigmoidf_(float x) { return __builtin_amdgcn_rcpf(1.0f + __builtin_amdgcn_exp2f(-1.44269504f * x)); }
__device__ __forceinline__ float gelu_tanh(float x) { const float y = 1.5957691216f * (x + 0.044715f * x * x * x); return x * sigmoidf_(y); }
__device__ __forceinline__ int lane_id() { int x; asm volatile("v_mbcnt_lo_u32_b32 %0, -1, 0\n\tv_mbcnt_hi_u32_b32 %0, -1, %0" : "=v"(x)); return x; }
__device__ __forceinline__ int launder_v(int x) { asm volatile("" : "+v"(x)); return x; }
__device__ __forceinline__ float shfl_xor_l(float v, int o, int lane) { return __int_as_float(__builtin_amdgcn_ds_bpermute(4 * (lane ^ o), __float_as_int(v))); }
__device__ __forceinline__ float wave_sum(float v, int lane) {
#pragma unroll
    for (int o = 1; o < 64; o <<= 1) v += shfl_xor_l(v, o, lane);
    return v;
}


#define XB_TMO      128
#define XB_XCNT(j)  (256  + 64 * (j))
#define XB_XSUB(j)  (1280 + 64 * (j))
#define XB_XGEN(j)  (2304 + 64 * (j))
#define XB_TOP      3328
#define XB_TOPGEN   3392
#define XCD_BAR_WORDS 3456
#define XB_SPIN_CAP (1u << 19)
__device__ __forceinline__ unsigned xb_ld(unsigned* p)              { return __hip_atomic_load(p, __ATOMIC_RELAXED, __HIP_MEMORY_SCOPE_AGENT); }
__device__ __forceinline__ unsigned xb_add(unsigned* p, unsigned v) { return __hip_atomic_fetch_add(p, v, __ATOMIC_RELAXED, __HIP_MEMORY_SCOPE_AGENT); }
__device__ __forceinline__ unsigned xb_xcc_id() { return (unsigned)__builtin_amdgcn_s_getreg((3 << 11) | 20) & 0xFu; }
#define XB_SPIN(cond, bar) do { unsigned _sp = 0; while (cond) { __builtin_amdgcn_s_sleep(1); \
    if ((++_sp & 255u) == 0u) { if (xb_ld(&(bar)[XB_TMO])) break; if (_sp > XB_SPIN_CAP) { atomicAdd(&(bar)[XB_TMO], 1u); break; } } } } while (0)
struct XcdBarrier { unsigned* bar; unsigned x; volatile LAS unsigned* st; };
__device__ __forceinline__ XcdBarrier xcd_barrier_post(unsigned* bar, volatile LAS unsigned* st) {
    XcdBarrier b; b.bar = bar; b.x = xb_xcc_id(); b.st = st;
    if (threadIdx.x == 0) (void)xb_add(&bar[XB_XCNT(b.x)], 1u);
    return b;
}
__device__ __forceinline__ void xcd_barrier_complete(unsigned* bar, unsigned x, unsigned& nloc, unsigned& nx) {
    const unsigned G = gridDim.x * gridDim.y * gridDim.z;
    unsigned sum, cnt, mine, sp = 0u;
    for (;;) {
        sum = 0u; cnt = 0u; mine = 0u;
#pragma unroll
        for (unsigned j = 0; j < 16; ++j) { const unsigned c = xb_ld(&bar[XB_XCNT(j)]); sum += c; cnt += (c > 0u) ? 1u : 0u; mine = (j == x) ? c : mine; }
        if (sum == G) break;
        __builtin_amdgcn_s_sleep(1);
        if ((++sp & 255u) == 0u) { if (xb_ld(&bar[XB_TMO])) break; if (sp > XB_SPIN_CAP) { atomicAdd(&bar[XB_TMO], 1u); break; } }
    }
    nloc = mine > 0u ? mine : 1u; nx = cnt > 0u ? cnt : 1u;
}
__device__ __forceinline__ void xcd_barrier(unsigned* bar_, volatile LAS unsigned* st_, int tid) {
    XcdBarrier b; b.bar = bar_; b.x = xb_xcc_id(); b.st = st_;
    asm volatile("s_waitcnt vmcnt(0)" ::: "memory");
    __syncthreads();
    if (tid == 0) {
        unsigned* bar = b.bar;
        __builtin_amdgcn_s_waitcnt(0);
        unsigned nloc = b.st[0], nx = b.st[1];
        if (nloc == 0u) { xcd_barrier_complete(bar, b.x, nloc, nx); b.st[0] = nloc; b.st[1] = nx; }
        const unsigned old = xb_add(&bar[XB_XSUB(b.x)], 1u);
        const unsigned gen = old / nloc;
        if (old + 1u == (gen + 1u) * nloc) {
            __builtin_amdgcn_fence(__ATOMIC_RELEASE, "agent");
            asm volatile("s_waitcnt vmcnt(0)" ::: "memory");
            const unsigned og = xb_add(&bar[XB_TOP], 1u);
            const unsigned tg = og / nx;
            if (og + 1u == (tg + 1u) * nx) xb_add(&bar[XB_TOPGEN], 1u);
            else XB_SPIN(xb_ld(&bar[XB_TOPGEN]) == tg, bar);
            __builtin_amdgcn_fence(__ATOMIC_ACQUIRE, "agent");
            xb_add(&bar[XB_XGEN(b.x)], 1u);
            asm volatile("s_waitcnt vmcnt(0)" ::: "memory");
        } else {
            XB_SPIN(xb_ld(&bar[XB_XGEN(b.x)]) == gen, bar);
            __builtin_amdgcn_fence(__ATOMIC_ACQUIRE, "agent");
            asm volatile("s_waitcnt vmcnt(0)" ::: "memory");
        }
    }
    __syncthreads();
}

struct Dep { unsigned* cl; unsigned* tmo; const unsigned* prevmix; const unsigned* prep; unsigned nprep; };
__device__ __forceinline__ unsigned* cnt_ptr(unsigned char* ws, int l, int stage) { return (unsigned*)(ws + WS_BAR + BAR_CNT_OFF) + (size_t)((l * 8 + stage) * NPANEL) * 64; }
__device__ __forceinline__ void dep_wait1(const unsigned* w, unsigned need, unsigned* tmo, int tid) {
    unsigned polls = 0;
    while ((unsigned)__builtin_amdgcn_readfirstlane(__hip_atomic_load(w, __ATOMIC_RELAXED, __HIP_MEMORY_SCOPE_AGENT)) < need) {
        if ((++polls & 255u) == 0u) { if (__builtin_amdgcn_readfirstlane(__hip_atomic_load(tmo, __ATOMIC_RELAXED, __HIP_MEMORY_SCOPE_AGENT)) != 0u) break;
            if (polls > (1u << 17)) { if (tid == 0) __hip_atomic_store(tmo, 1u, __ATOMIC_RELAXED, __HIP_MEMORY_SCOPE_AGENT); break; } }
        __builtin_amdgcn_s_sleep(2); }
}
__device__ __forceinline__ void dep_wait(const unsigned* w, unsigned need, unsigned* tmo, int tid) {
    if (tid < 64) { dep_wait1(w, need, tmo, tid); __builtin_amdgcn_fence(__ATOMIC_ACQUIRE, "agent"); asm volatile("s_waitcnt vmcnt(0)" ::: "memory"); }
    asm volatile("" ::: "memory"); __builtin_amdgcn_s_barrier(); asm volatile("" ::: "memory");
}
__device__ __forceinline__ void dep_wait2(const unsigned* w0, const unsigned* w1, unsigned need, unsigned* tmo, int tid) {
    if (tid < 64) { dep_wait1(w0, need, tmo, tid); dep_wait1(w1, need, tmo, tid); __builtin_amdgcn_fence(__ATOMIC_ACQUIRE, "agent"); asm volatile("s_waitcnt vmcnt(0)" ::: "memory"); }
    asm volatile("" ::: "memory"); __builtin_amdgcn_s_barrier(); asm volatile("" ::: "memory");
}
template <class Sel>
__device__ __forceinline__ void dep_wait_many(const unsigned* cbase, int n, unsigned need, unsigned* tmo, int tid, const Sel& sel) {
    if (tid < 64) { unsigned polls = 0;
        for (;;) { const unsigned a = tid < n ? __hip_atomic_load(cbase + 64 * sel(tid), __ATOMIC_RELAXED, __HIP_MEMORY_SCOPE_AGENT) : need;
            const unsigned b = tid + 64 < n ? __hip_atomic_load(cbase + 64 * sel(tid + 64), __ATOMIC_RELAXED, __HIP_MEMORY_SCOPE_AGENT) : need;
            if (__all(a >= need && b >= need)) break;
            if ((++polls & 255u) == 0u) { if (__builtin_amdgcn_readfirstlane(__hip_atomic_load(tmo, __ATOMIC_RELAXED, __HIP_MEMORY_SCOPE_AGENT)) != 0u) break;
                if (polls > (1u << 17)) { if (tid == 0) __hip_atomic_store(tmo, 1u, __ATOMIC_RELAXED, __HIP_MEMORY_SCOPE_AGENT); break; } }
            __builtin_amdgcn_s_sleep(2); }
        __builtin_amdgcn_fence(__ATOMIC_ACQUIRE, "agent"); asm volatile("s_waitcnt vmcnt(0)" ::: "memory"); }
    asm volatile("" ::: "memory"); __builtin_amdgcn_s_barrier(); asm volatile("" ::: "memory");
}
__device__ __forceinline__ void dep_wait3(const unsigned* w0, unsigned n0, const unsigned* w1, unsigned n1, const unsigned* w2, unsigned n2, unsigned* tmo, int tid) {
    if (tid < 64) { dep_wait1(w0, n0, tmo, tid); dep_wait1(w1, n1, tmo, tid); dep_wait1(w2, n2, tmo, tid); __builtin_amdgcn_fence(__ATOMIC_ACQUIRE, "agent"); asm volatile("s_waitcnt vmcnt(0)" ::: "memory"); }
    asm volatile("" ::: "memory"); __builtin_amdgcn_s_barrier(); asm volatile("" ::: "memory");
}
__device__ __forceinline__ void dep_done_wt(unsigned* c, int tid, unsigned inc = 1u) {
    asm volatile("s_waitcnt vmcnt(0)" ::: "memory"); __builtin_amdgcn_s_barrier(); asm volatile("" ::: "memory");
    if (tid == 0) __hip_atomic_fetch_add(c, inc, __ATOMIC_RELAXED, __HIP_MEMORY_SCOPE_AGENT);
}
__device__ __forceinline__ void dep_done(unsigned* c, int tid) {
    asm volatile("s_waitcnt vmcnt(0)" ::: "memory"); __builtin_amdgcn_s_barrier(); asm volatile("" ::: "memory");
    if (tid == 0) { __builtin_amdgcn_fence(__ATOMIC_RELEASE, "agent"); asm volatile("s_waitcnt vmcnt(0)" ::: "memory"); __hip_atomic_fetch_add(c, 1u, __ATOMIC_RELAXED, __HIP_MEMORY_SCOPE_AGENT); }
}

constexpr int BM = 256, BK = 64, HALF = 128, HTB = HALF * BK * 2, NXCD = 8, WGM = 8;
__device__ __forceinline__ int lds_byte(int r, int c) { const int st = (r >> 4) * 2 + (c >> 5), rr = r & 15, cc = c & 31, ob = rr * 64 + cc * 2; return st * 1024 + (ob ^ (((ob >> 9) & 1) << 5)); }
__device__ __forceinline__ void stage_rc(int b, int& R, int& C) { const int st = b / 1024, sb = b % 1024, swz = sb ^ (((sb >> 9) & 1) << 5); R = (st >> 1) * 16 + swz / 64; C = (st & 1) * 32 + (swz % 64) / 2; }
__device__ __forceinline__ int perm32(int rho) { const int n = rho >> 4, i = rho & 15; return 8 * (i >> 2) + 4 * n + (i & 3); }

struct Unit { int pm, pn, sub; };
__device__ __forceinline__ bool tile_of(long L, int nM, int nN, int& pm, int& pn) {
    const int nwg = nM * nN; if (L >= nwg) return false;
    int wgid = (int)L; { const int q = nwg / NXCD, r = nwg % NXCD, xcd = wgid % NXCD, off = wgid / NXCD; wgid = (xcd < r ? xcd * (q + 1) : r * (q + 1) + (xcd - r) * q) + off; }
    const int nig = WGM * nN, gid = wgid / nig, fm = gid * WGM, gsz = (nM - fm) < WGM ? (nM - fm) : WGM;
    pm = fm + ((wgid % nig) % gsz); pn = (wgid % nig) / gsz; return true;
}
template <int MODE, int SCHED>
__device__ __forceinline__ bool get_unit(int i, int G, int c, int nM, int nN, int NT, Unit& u, int& kofs, int& nt) {
    const int round = MODE == 1 ? (i >> 1) : i;
    if (MODE == 1) { u.sub = i & 1; kofs = u.sub * 512; nt = u.sub ? 16 : 8; } else { u.sub = 0; kofs = 0; nt = NT; }
    if (SCHED == 0 || G != 256) return tile_of((long)round * G + c, nM, nN, u.pm, u.pn);
    const int v = (c & 7) * 32 + (c >> 3), h = v >> 4, p = v - h - 1; const bool heavy = (v & 15) == 0;
    if (SCHED == 1) {
        if (heavy) return false;
        const int x = p / 30, q = p - 30 * x, tl = round * 30 + q; if (tl >= 136) return false;
        u.pm = tl >> 1; u.pn = 2 * x + (tl & 1); return true;
    } else if (SCHED == 2) {
        int j;
        if (heavy) { if (round >= 2) return false; j = h * 2 + round; }
        else { if (round >= 1) return false; const int x = p / 30, q = p - 30 * x; j = (q >= 16) ? 32 + x * 14 + (q - 16) : 144 + x * 16 + q; }
        u.pm = j >> 2; u.pn = j & 3; return true;
    } else if (SCHED == 3) {
        int j;
        if (heavy) { if (round >= 2) return false; j = 240 + round * 16 + h; } else { if (round >= 1) return false; j = p; }
        u.pm = j >> 2; u.pn = j & 3; return true;
    } else {
        if (heavy) return false;
        int j;
        if (round == 0) j = p; else if (round == 1 && p < 32) j = 240 + p; else return false;
        u.pm = j >> 2; u.pn = j & 3; return true;
    }
}

template <int MODE, int SCHED, int WST, int NEED, int DST, class Epi>
__device__ __forceinline__ void gemm_phase(const int wid_, LAS unsigned char* lds, const bf16_t* Ab, const size_t tstepA, const bf16_t* Bb, const int ld, const int nM, const int nN, const Epi& E, const Dep& dep) {
    const int wid = wid_, lane = launder_v(lane_id()), tid = wid * 64 + lane, wr = wid >> 2, wc = wid & 3, fr = lane & 15, fq = lane >> 4;
    const int G = gridDim.x, c = blockIdx.x;
    unsigned voffA[2], voffB[2];
#pragma unroll
    for (int i = 0; i < 2; ++i) { int R, C; stage_rc(tid * 16 + i * 8192, R, C); const int Rb = (R & ~31) + perm32(R & 31);
        voffA[i] = (unsigned)(R * ld + C) * 2u; voffB[i] = (unsigned)(Rb * ld + C) * 2u; }
    const size_t kstep = (size_t)(BK * 2);
    const size_t hstep = (size_t)HALF * ld * 2, tstepB = 2 * hstep;
    const int NT = ld / BK;
    const unsigned ldsw = (unsigned)wid * 1024u;
    const int aoff = lds_byte(wr * 64 + fr, fq * 8), boff = lds_byte(wc * 32 + fr, fq * 8);
#define PG8_SA(b, h) (((b) * 2 + (h)) * HTB)
#define PG8_SB(b, h) ((4 + (b) * 2 + (h)) * HTB)
#define PG8_STAGE(bufoff, gbase, voff) do { _Pragma("unroll") for (int _i = 0; _i < 2; ++_i) \
        __builtin_amdgcn_global_load_lds((const unsigned*)((const char*)(gbase) + (voff)[_i]), (LAS unsigned*)(lds + (bufoff) + ldsw + _i * 8192), 16, 0, 0); } while (0)
#define PG8_LDA(dst, b, h) do { _Pragma("unroll") for (int m = 0; m < 4; ++m) _Pragma("unroll") for (int k = 0; k < 2; ++k) dst[m][k] = *(const LAS bf16x8*)(lds + PG8_SA(b, h) + aoff + m * 2048 + k * 1024); } while (0)
#define PG8_LDB(dst, b, h) do { _Pragma("unroll") for (int n = 0; n < 2; ++n) _Pragma("unroll") for (int k = 0; k < 2; ++k) dst[n][k] = *(const LAS bf16x8*)(lds + PG8_SB(b, h) + boff + n * 2048 + k * 1024); } while (0)
#define PG8_MMA(ai, bj, At, Bt) do { __builtin_amdgcn_s_setprio(1); _Pragma("unroll") for (int m = 0; m < 4; ++m) _Pragma("unroll") for (int n = 0; n < 2; ++n) _Pragma("unroll") for (int k = 0; k < 2; ++k) \
        acc[ai][bj][m][n] = __builtin_amdgcn_mfma_f32_16x16x32_bf16(Bt[n][k], At[m][k], acc[ai][bj][m][n], 0, 0, 0); __builtin_amdgcn_s_setprio(0); } while (0)
#define PG8_WAIT_V(n) asm volatile("s_waitcnt vmcnt(" #n ")" ::: "memory")
#define PG8_WAIT_L(n) asm volatile("s_waitcnt lgkmcnt(" #n ")" ::: "memory")
#define PG8_BAR __builtin_amdgcn_s_barrier()
#define PG8_SCHED __builtin_amdgcn_sched_barrier(0)
    Unit cur, nxt; int ui = 0, kofs, nt, nkofs = 0, nnt = 0, pend = -1;
    if (!get_unit<MODE, SCHED>(0, G, c, nM, nN, NT, cur, kofs, nt)) return;
    f32x4 acc[2][2][4][2];
#pragma unroll
    for (int a = 0; a < 2; ++a)
#pragma unroll
        for (int b = 0; b < 2; ++b)
#pragma unroll
            for (int m = 0; m < 4; ++m)
#pragma unroll
                for (int n = 0; n < 2; ++n) acc[a][b][m][n] = (f32x4){0.f, 0.f, 0.f, 0.f};
    bf16x8 At[4][2], B0[2][2], B1[2][2];
    const char* cA = (const char*)Ab + (size_t)cur.pm * tstepA + (size_t)kofs * 2; const char* cB = (const char*)Bb + (size_t)cur.pn * tstepB + (size_t)kofs * 2;
    if (NEED > 0) { if (WST == C_X) { const int q = cur.pm + 1 < NPANEL ? cur.pm + 1 : cur.pm; dep_wait3(dep.cl + (WST * NPANEL + cur.pm) * 64, (unsigned)NEED, dep.prevmix + 64 * q, dep.prevmix == dep.prep ? 0u : 24u, dep.prep, dep.nprep, dep.tmo, tid); }
                    else dep_wait(dep.cl + (WST * NPANEL + cur.pm) * 64, (unsigned)NEED, dep.tmo, tid); }
    PG8_STAGE(PG8_SB(0, 0), cB, voffB); PG8_STAGE(PG8_SB(0, 1), cB + hstep, voffB); PG8_STAGE(PG8_SA(0, 0), cA, voffA); PG8_STAGE(PG8_SA(0, 1), cA + hstep, voffA);
    if (wr == 1) PG8_BAR;
    PG8_WAIT_V(2); PG8_BAR;
    PG8_STAGE(PG8_SB(1, 0), cB + kstep, voffB); PG8_STAGE(PG8_SA(1, 0), cA + kstep, voffA); PG8_STAGE(PG8_SB(1, 1), cB + hstep + kstep, voffB);
    PG8_WAIT_V(6); PG8_BAR;
    for (;;) {
        const bool has_next = get_unit<MODE, SCHED>(ui + 1, G, c, nM, nN, NT, nxt, nkofs, nnt);
        const char* nA = has_next ? (const char*)Ab + (size_t)nxt.pm * tstepA + (size_t)nkofs * 2 : cA; const char* nB = has_next ? (const char*)Bb + (size_t)nxt.pn * tstepB + (size_t)nkofs * 2 : cB;
        const int ntc = MODE == 0 ? NT : nt;
        for (int t = 0; t < ntc; t += 2) {
            const bool last = (t == ntc - 2);
            const char* a1 = cA + (size_t)(t + 1) * kstep;
            const char* a2 = last ? nA : cA + (size_t)(t + 2) * kstep; const char* b2 = last ? nB : cB + (size_t)(t + 2) * kstep;
            const char* a3 = a2 + kstep; const char* b3 = b2 + kstep;
#if !MK_NOHOOK
            if (NEED > 0 && last && has_next && (MODE == 0 || nxt.sub == 0)) { if (WST == C_X) { const int q = nxt.pm + 1 < NPANEL ? nxt.pm + 1 : nxt.pm; dep_wait3(dep.cl + (WST * NPANEL + nxt.pm) * 64, (unsigned)NEED, dep.prevmix + 64 * q, dep.prevmix == dep.prep ? 0u : 24u, dep.prep, dep.nprep, dep.tmo, tid); }
                else dep_wait(dep.cl + (WST * NPANEL + nxt.pm) * 64, (unsigned)NEED, dep.tmo, tid); }
#endif
            PG8_LDB(B0, 0, 0); PG8_LDB(B1, 0, 1); PG8_SCHED; PG8_LDA(At, 0, 0); PG8_STAGE(PG8_SA(1, 1), a1 + hstep, voffA);
            PG8_WAIT_V(8); PG8_WAIT_L(0); PG8_BAR; PG8_MMA(0, 0, At, B0); PG8_MMA(0, 1, At, B1); PG8_BAR; PG8_SCHED;
            PG8_LDA(At, 0, 1); PG8_STAGE(PG8_SB(0, 0), b2, voffB); PG8_STAGE(PG8_SB(0, 1), b2 + hstep, voffB); PG8_STAGE(PG8_SA(0, 0), a2, voffA);
            PG8_WAIT_V(8); PG8_WAIT_L(0); PG8_BAR; PG8_MMA(1, 0, At, B0); PG8_MMA(1, 1, At, B1); PG8_BAR; PG8_SCHED;
            PG8_LDB(B0, 1, 0); PG8_LDB(B1, 1, 1); PG8_SCHED; PG8_LDA(At, 1, 0); PG8_STAGE(PG8_SA(0, 1), a2 + hstep, voffA);
            PG8_WAIT_V(8); PG8_WAIT_L(0); PG8_BAR; PG8_MMA(0, 0, At, B0); PG8_MMA(0, 1, At, B1); PG8_BAR; PG8_SCHED;
            PG8_LDA(At, 1, 1); PG8_STAGE(PG8_SB(1, 0), b3, voffB); PG8_STAGE(PG8_SB(1, 1), b3 + hstep, voffB); PG8_STAGE(PG8_SA(1, 0), a3, voffA);
            PG8_WAIT_V(8); PG8_WAIT_L(0); PG8_BAR; PG8_MMA(1, 0, At, B0); PG8_MMA(1, 1, At, B1); PG8_BAR; PG8_SCHED;
        }
        if (wr == 0) PG8_BAR;
        if (DST >= 0 && pend >= 0) { PG8_WAIT_V(0); if (lane_id() == 0) __hip_atomic_fetch_add(dep.cl + (DST * NPANEL + pend) * 64, 1u, __ATOMIC_RELAXED, __HIP_MEMORY_SCOPE_AGENT); pend = -1; }
        E(acc, cur, wr, wc, lane);
        if (DST >= 0 && (MODE == 0 || cur.sub == 1)) {
            if (SCHED == 1 && ui == 0) { PG8_WAIT_V(0); if (lane_id() == 0) __hip_atomic_fetch_add(dep.cl + (DST * NPANEL + cur.pm) * 64, 1u, __ATOMIC_RELAXED, __HIP_MEMORY_SCOPE_AGENT); }
            else pend = cur.pm; }
        if (!has_next) break;
        if (MODE == 0 || cur.sub == 1)
#pragma unroll
        for (int a = 0; a < 2; ++a)
#pragma unroll
            for (int b = 0; b < 2; ++b)
#pragma unroll
                for (int m = 0; m < 4; ++m)
#pragma unroll
                    for (int n = 0; n < 2; ++n) acc[a][b][m][n] = (f32x4){0.f, 0.f, 0.f, 0.f};
        cur = nxt; cA = nA; cB = nB; nt = nnt; ++ui;
        if (wr == 1) PG8_BAR;
    }
    PG8_WAIT_V(0);
    if (DST >= 0 && pend >= 0 && lane_id() == 0) __hip_atomic_fetch_add(dep.cl + (DST * NPANEL + pend) * 64, 1u, __ATOMIC_RELAXED, __HIP_MEMORY_SCOPE_AGENT);
    PG8_BAR;
#undef PG8_SA
#undef PG8_SB
#undef PG8_STAGE
#undef PG8_LDA
#undef PG8_LDB
#undef PG8_MMA
#undef PG8_WAIT_V
#undef PG8_WAIT_L
#undef PG8_BAR
#undef PG8_SCHED
}

struct EpiIn {
    unsigned char* ws;
    __device__ __forceinline__ void operator()(const f32x4 (&acc)[2][2][4][2], const Unit& u, int wr, int wc, int lane_) const {
        const int ln = launder_v(lane_), fr = ln & 15, fq = ln >> 4;
        const int lr0 = wr * 64 + fr, cw = wc * 32 + 8 * fq, pn = u.pn;
        const float* rstd = (const float*)(ws + WS_RSA) + u.pm * BM; float* lnpart = (float*)(ws + WS_LNP);
        float rsv[2][4];
#pragma unroll
        for (int ai = 0; ai < 2; ++ai)
#pragma unroll
            for (int m = 0; m < 4; ++m) rsv[ai][m] = rstd[lr0 + ai * HALF + m * 16];
        if (pn < 2) {
            bf16_t* ab = (bf16_t*)(ws + WS_AF + (size_t)u.pm * AF_BLK);
#pragma unroll
            for (int ai = 0; ai < 2; ++ai)
#pragma unroll
                for (int m = 0; m < 4; ++m) { const int lr = lr0 + ai * HALF + m * 16; const float rs = rsv[ai][m];
#pragma unroll
                    for (int bj = 0; bj < 2; ++bj) { const f32x4 v0 = acc[ai][bj][m][0] * rs, v1 = acc[ai][bj][m][1] * rs;
                        u32x4 w; w.x = cvt_pk_bf16(v0[0], v0[1]); w.y = cvt_pk_bf16(v0[2], v0[3]); w.z = cvt_pk_bf16(v1[0], v1[1]); w.w = cvt_pk_bf16(v1[2], v1[3]);
                        { const unsigned vo = (unsigned)(lr * WA + pn * BM + cw) * 2u; if (bj == 0) st16_wt<0>(ab, vo, w); else st16_wt<256>(ab, vo, w); } }
                    asm volatile("" ::: "memory"); }
        } else {
            const int seg = (pn - 2) >> 2, colb = ((pn - 2) & 3) * BM + cw;
            bf16_t* O = (bf16_t*)(ws + WS_BIG + (size_t)u.pm * BIG_BLK + (size_t)seg * SEG_B);
            if (seg < 2) {
#pragma unroll
                for (int ai = 0; ai < 2; ++ai)
#pragma unroll
                    for (int m = 0; m < 4; ++m) { const int lr = lr0 + ai * HALF + m * 16, gr = u.pm * BM + lr; const float rs = rsv[ai][m]; const unsigned vo = (unsigned)(lr * D + colb) * 2u;
                        float s1 = 0.f, s2 = 0.f;
#pragma unroll
                        for (int bj = 0; bj < 2; ++bj) { float v[8];
#pragma unroll
                            for (int j = 0; j < 4; ++j) { v[j] = acc[ai][bj][m][0][j] * rs; v[4 + j] = acc[ai][bj][m][1][j] * rs; }
#pragma unroll
                            for (int j = 0; j < 8; ++j) { const float x = v[j], e = x * (-0.102943240f * (x * x) + -2.30220819f); v[j] = x * __builtin_amdgcn_rcpf(1.0f + __builtin_amdgcn_exp2f(e)); s1 += v[j]; s2 += v[j] * v[j]; }
                            u32x4 w; w.x = cvt_pk_bf16(v[0], v[1]); w.y = cvt_pk_bf16(v[2], v[3]); w.z = cvt_pk_bf16(v[4], v[5]); w.w = cvt_pk_bf16(v[6], v[7]);
                            if (bj == 0) st16_wt<0>(O, vo, w); else st16_wt<256>(O, vo, w); }
                        if (seg == 1) { s1 += shfl_xor_l(s1, 16, ln); s1 += shfl_xor_l(s1, 32, ln); s2 += shfl_xor_l(s2, 16, ln); s2 += shfl_xor_l(s2, 32, ln);
                            if (fq == 0) st8_wt(lnpart + ((size_t)gr * 16 + (pn - 6) * 4 + wc) * 2, (f32x2){s1, s2}); }
                        asm volatile("" ::: "memory"); }
            } else {
#pragma unroll
                for (int ai = 0; ai < 2; ++ai)
#pragma unroll
                    for (int m = 0; m < 4; ++m) { const int lr = lr0 + ai * HALF + m * 16; const float rs = rsv[ai][m] * -1.44269504f; bf16_t* rowp = O + (size_t)lr * D + colb;
#pragma unroll
                        for (int bj = 0; bj < 2; ++bj) { float v[8];
#pragma unroll
                            for (int j = 0; j < 4; ++j) { v[j] = acc[ai][bj][m][0][j] * rs; v[4 + j] = acc[ai][bj][m][1][j] * rs; }
#pragma unroll
                            for (int j = 0; j < 8; ++j) v[j] = __builtin_amdgcn_rcpf(1.0f + __builtin_amdgcn_exp2f(v[j]));
                            u32x4 w; w.x = cvt_pk_bf16(v[0], v[1]); w.y = cvt_pk_bf16(v[2], v[3]); w.z = cvt_pk_bf16(v[4], v[5]); w.w = cvt_pk_bf16(v[6], v[7]);
                            if (bj == 0) st16_wt<0>(O, (unsigned)(lr * D + colb) * 2u, w); else st16_wt<256>(O, (unsigned)(lr * D + colb) * 2u, w); } }
            }
        }
    }
};
struct EpiAB {
    unsigned char* ws; unsigned char* mscr;
    __device__ __forceinline__ void operator()(f32x4 (&acc)[2][2][4][2], const Unit& u, int wr, int wc, int lane_) const {
        const int ln = launder_v(lane_), fr = ln & 15, fq = ln >> 4;
        const int lr0 = wr * 64 + fr, col0 = u.pn * BM + wc * 32 + 8 * fq;
        const bf16_t* SA = (const bf16_t*)(ws + WS_BIG + (size_t)u.pm * BIG_BLK + 2 * SEG_B); const bf16_t* SB = SA + SEG_B / 2;
        bf16_t* mo = (bf16_t*)mscr + (size_t)u.pm * BM * D;
#pragma unroll
        for (int ai = 0; ai < 2; ++ai) {
            u32x4 gb[4][2], ga[4][2];
#pragma unroll
            for (int m = 0; m < 4; ++m)
#pragma unroll
                for (int bj = 0; bj < 2; ++bj) { const size_t off = (size_t)(lr0 + ai * HALF + m * 16) * D + col0 + bj * HALF; gb[m][bj] = *(const u32x4*)(SB + off); if (u.sub == 0) ga[m][bj] = *(const u32x4*)(SA + off); }
#pragma unroll
            for (int m = 0; m < 4; ++m)
#pragma unroll
                for (int bj = 0; bj < 2; ++bj) { const size_t off = (size_t)(lr0 + ai * HALF + m * 16) * D + col0 + bj * HALF; const u32x4 b = gb[m][bj];
                    f32x4 s0 = (f32x4){bf_lo(b.x), bf_hi(b.x), bf_lo(b.y), bf_hi(b.y)}, s1 = (f32x4){bf_lo(b.z), bf_hi(b.z), bf_lo(b.w), bf_hi(b.w)};
#pragma unroll
                    for (int j = 0; j < 4; ++j) { s0[j] = fmaxf(s0[j], 1e-30f); s1[j] = fmaxf(s1[j], 1e-30f); }
                    if (u.sub == 0) { const u32x4 a = ga[m][bj];
#pragma unroll
                        for (int j = 0; j < 4; ++j) { s0[j] = __builtin_amdgcn_rcpf(s0[j]); s1[j] = __builtin_amdgcn_rcpf(s1[j]); }
                        acc[ai][bj][m][0] = acc[ai][bj][m][0] * (s0 * (f32x4){bf_lo(a.x), bf_hi(a.x), bf_lo(a.y), bf_hi(a.y)});
                        acc[ai][bj][m][1] = acc[ai][bj][m][1] * (s1 * (f32x4){bf_lo(a.z), bf_hi(a.z), bf_lo(a.w), bf_hi(a.w)});
                    } else { const f32x4 v0 = acc[ai][bj][m][0] * s0, v1 = acc[ai][bj][m][1] * s1;
                        u32x4 w; w.x = cvt_pk_bf16(v0[0], v0[1]); w.y = cvt_pk_bf16(v0[2], v0[3]); w.z = cvt_pk_bf16(v1[0], v1[1]); w.w = cvt_pk_bf16(v1[2], v1[3]);
                        st16_wt<0>(mo, (unsigned)off * 2u, w); } }
            asm volatile("" ::: "memory"); }
    }
};
struct EpiF {
    unsigned char* fptr; size_t fblk;
    __device__ __forceinline__ void operator()(const f32x4 (&acc)[2][2][4][2], const Unit& u, int wr, int wc, int lane_) const {
        const int ln = launder_v(lane_), fr = ln & 15, fq = ln >> 4;
        const int lr0 = wr * 64 + fr, col0 = u.pn * BM + wc * 32 + 8 * fq;
        bf16_t* fo = (bf16_t*)(fptr + (size_t)u.pm * fblk);
#pragma unroll
        for (int ai = 0; ai < 2; ++ai)
#pragma unroll
            for (int m = 0; m < 4; ++m) { const unsigned vo = (unsigned)((lr0 + ai * HALF + m * 16) * D + col0) * 2u;
#pragma unroll
                for (int bj = 0; bj < 2; ++bj) { const f32x4 v0 = acc[ai][bj][m][0], v1 = acc[ai][bj][m][1];
                    u32x4 w; w.x = cvt_pk_bf16(v0[0], v0[1]); w.y = cvt_pk_bf16(v0[2], v0[3]); w.z = cvt_pk_bf16(v1[0], v1[1]); w.w = cvt_pk_bf16(v1[2], v1[3]);
                    if (bj == 0) st16_wt<0>(fo, vo, w); else st16_wt<256>(fo, vo, w); }
                asm volatile("" ::: "memory"); }
    }
};
struct EpiUp {
    unsigned char* ws;
    __device__ __forceinline__ void operator()(const f32x4 (&acc)[2][2][4][2], const Unit& u, int wr, int wc, int lane_) const {
        const int ln = launder_v(lane_), fr = ln & 15, fq = ln >> 4;
        const int lr0 = wr * 64 + fr, col0 = u.pn * BM + wc * 32 + 8 * fq;
        bf16_t* ro = (bf16_t*)(ws + WS_BIG + (size_t)u.pm * BIG_BLK); const float* rstd = (const float*)(ws + WS_RSB) + u.pm * BM;
        float rsv[2][4];
#pragma unroll
        for (int ai = 0; ai < 2; ++ai)
#pragma unroll
            for (int m = 0; m < 4; ++m) rsv[ai][m] = rstd[lr0 + ai * HALF + m * 16];
#pragma unroll
        for (int ai = 0; ai < 2; ++ai)
#pragma unroll
            for (int m = 0; m < 4; ++m) { const int lr = lr0 + ai * HALF + m * 16; const float rs = rsv[ai][m]; const unsigned vo = (unsigned)(lr * DFF + col0) * 2u;
#pragma unroll
                for (int bj = 0; bj < 2; ++bj) { float v[8];
#pragma unroll
                    for (int j = 0; j < 4; ++j) { v[j] = acc[ai][bj][m][0][j] * rs; v[4 + j] = acc[ai][bj][m][1][j] * rs; }
#pragma unroll
                    for (int j = 0; j < 8; ++j) { v[j] = fmaxf(v[j], 0.f); v[j] = v[j] * v[j]; }
                    u32x4 w; w.x = cvt_pk_bf16(v[0], v[1]); w.y = cvt_pk_bf16(v[2], v[3]); w.z = cvt_pk_bf16(v[4], v[5]); w.w = cvt_pk_bf16(v[6], v[7]);
                    if (bj == 0) st16_wt<0>(ro, vo, w); else st16_wt<256>(ro, vo, w); }
                asm volatile("" ::: "memory"); }
    }
};

__device__ __forceinline__ void transpose_item(const float* W, int K, int N, bf16_t* WT, int ldt, int coff, const float* sc, LAS float* scr, int item, int lane) {
    const int nblk = N / 32, kb = item / nblk, nb = item % nblk, k0 = 64 * kb, n0 = 32 * nb;
    float tv[32];
#pragma unroll
    for (int i = 0; i < 32; ++i) { const int kk = 2 * i + (lane >> 5); tv[i] = W[(size_t)(k0 + kk) * N + n0 + (lane & 31)]; }
#pragma unroll
    for (int i = 0; i < 32; ++i) { const int kk = 2 * i + (lane >> 5); float v = tv[i]; if (sc) v *= sc[k0 + kk]; scr[kk * 33 + (lane & 31)] = v; }
    asm volatile("s_waitcnt lgkmcnt(0)" ::: "memory");
    const int c = lane & 7;
#pragma unroll
    for (int j = 0; j < 4; ++j) { const int n = (lane >> 3) + 8 * j; const LAS float* s = scr + (8 * c) * 33 + n;
        u32x4 o; o.x = cvt_pk_bf16(s[0 * 33], s[1 * 33]); o.y = cvt_pk_bf16(s[2 * 33], s[3 * 33]); o.z = cvt_pk_bf16(s[4 * 33], s[5 * 33]); o.w = cvt_pk_bf16(s[6 * 33], s[7 * 33]);
        st16_wt<0>(WT, (unsigned)((n0 + n) * ldt + coff + k0 + 8 * c) * 2u, o); }
    asm volatile("s_waitcnt lgkmcnt(0)" ::: "memory");
}
struct Params { const float* in[19]; float* out; unsigned char* ws; int ph_lo, ph_hi; };
typedef const __attribute__((address_space(4))) Params Ptrs;
__device__ __forceinline__ Ptrs* kargs() { Ptrs* p = (Ptrs*)__builtin_amdgcn_kernarg_segment_ptr(); asm volatile("" : "+s"(p)); return p; }

__device__ __forceinline__ void prep_layer(Ptrs& P, int l, LAS unsigned char* lds, int wave, int lane, int wg, int nwg) {
    LAS float* scr = (LAS float*)(lds + wave * 8704);
    const int gw = wg * 8 + wave, NGW = nwg * 8;
    unsigned char* wb = P.ws + (size_t)(l & 1) * WBLK;
    const float* w_in = P.in[3] + (size_t)l * D * DIN; const float* w_pg = P.in[4] + (size_t)l * 4 * 128 * 128; const float* pscale = P.in[5] + (size_t)l * WA;
    const float* w_sp = P.in[6] + (size_t)l * 8 * 128 * 128; const float* w_ba = P.in[10] + (size_t)l * WA * D; const float* w_bb = P.in[11] + (size_t)l * D * D;
    const float* w_out = P.in[12] + (size_t)l * D * D; const float* w_up = P.in[13] + (size_t)l * D * DFF; const float* w_dn = P.in[14] + (size_t)l * DFF * D;
    const float* g1 = P.in[15] + (size_t)l * D; const float* g3 = P.in[17] + (size_t)l * D;
    constexpr int I_IN = (D / 64) * (DIN / 32), I_BB = (D / 64) * (D / 32), I_OUT = I_BB, I_UP = (D / 64) * (DFF / 32), I_DN = (DFF / 64) * (D / 32), I_FOLD = 4 * 32 * 16, I_SP = 256;
    constexpr int NITEMS = I_IN + I_BB + I_OUT + I_UP + I_DN + I_FOLD + I_SP;
    for (int it = gw; it < NITEMS; it += NGW) {
        int r = it;
        if (r < I_IN) { transpose_item(w_in, D, DIN, (bf16_t*)(wb + WOFF_IN), D, 0, g1, scr, r, lane); continue; } r -= I_IN;
        if (r < I_BB) { transpose_item(w_bb, D, D, (bf16_t*)(wb + WOFF_AB), KAB, 512, nullptr, scr, r, lane); continue; } r -= I_BB;
        if (r < I_OUT) { transpose_item(w_out, D, D, (bf16_t*)(wb + WOFF_OUT), D, 0, nullptr, scr, r, lane); continue; } r -= I_OUT;
        if (r < I_UP) { transpose_item(w_up, D, DFF, (bf16_t*)(wb + WOFF_UP), D, 0, g3, scr, r, lane); continue; } r -= I_UP;
        if (r < I_DN) { transpose_item(w_dn, DFF, D, (bf16_t*)(wb + WOFF_DN), DFF, 0, nullptr, scr, r, lane); continue; } r -= I_DN;
        if (r < I_FOLD) {
            const int g = r >> 9, cb = (r >> 4) & 31, nb = r & 15, n = nb * 64 + lane;
            float acc[4] = {0.f, 0.f, 0.f, 0.f};
            const float* pg = w_pg + ((size_t)g * 128 + cb * 4) * 128;
            for (int d0 = 0; d0 < 128; d0 += 16) { float wv[16];
#pragma unroll
                for (int q = 0; q < 16; ++q) wv[q] = w_ba[(size_t)(g * 128 + d0 + q) * D + n];
#pragma unroll
                for (int q = 0; q < 16; ++q) { const float x = wv[q] * pscale[g * 128 + d0 + q];
#pragma unroll
                    for (int j = 0; j < 4; ++j) acc[j] += pg[j * 128 + d0 + q] * x; } }
            u32x2 o; o.x = cvt_pk_bf16(acc[0], acc[1]); o.y = cvt_pk_bf16(acc[2], acc[3]);
            st8b_wt(wb + WOFF_AB, (unsigned)(n * KAB + g * 128 + cb * 4) * 2u, o); continue; } r -= I_FOLD;
        {
            const int e0 = r * 512 + lane * 8, s0 = e0 & 127, t = (e0 >> 7) & 127;
            const f32x4 x0 = *(const f32x4*)(w_sp + e0), x1 = *(const f32x4*)(w_sp + e0 + 4); float v[8] = {x0[0], x0[1], x0[2], x0[3], x1[0], x1[1], x1[2], x1[3]};
#pragma unroll
            for (int j = 0; j < 8; ++j) v[j] = (s0 + j <= t) ? v[j] : 0.f;
            u32x4 o; o.x = cvt_pk_bf16(v[0], v[1]); o.y = cvt_pk_bf16(v[2], v[3]); o.z = cvt_pk_bf16(v[4], v[5]); o.w = cvt_pk_bf16(v[6], v[7]);
            st16_wt<0>(wb + WOFF_SP, (unsigned)e0 * 2u, o); }
    }
}

__device__ __forceinline__ unsigned* ticket_ptr(unsigned char* ws, int l, int k) { return cnt_ptr(ws, 5, 0) + 64 * (8 + l * 3 + k); }
__device__ __forceinline__ int claim_bcast(unsigned v, volatile LAS unsigned* slot, int tid) { if (tid == 0) slot[0] = v; __syncthreads(); const int r = (int)slot[0]; __syncthreads(); return r; }

__device__ __forceinline__ void phase_r0(Ptrs& P, int tid, int wave, int lane) {
    bf16_t* xb = (bf16_t*)(P.ws + WS_XB); float* rsa = (float*)(P.ws + WS_RSA);
    for (int it = blockIdx.x; it < NPANEL * 8; it += gridDim.x) {
        for (int i = 0; i < 4; ++i) { const int m = it * 32 + wave * 4 + i;
            const float* src = m < MP ? P.in[0] + (size_t)m * D : P.in[1] + (size_t)(m - MP) * D;
            f32x4 v[4]; float ss = 0.f;
#pragma unroll
            for (int j = 0; j < 4; ++j) { v[j] = *(const f32x4*)(src + 256 * j + 4 * lane); ss += (v[j][0] * v[j][0] + v[j][1] * v[j][1]) + (v[j][2] * v[j][2] + v[j][3] * v[j][3]); }
            ss = wave_sum(ss, lane);
#pragma unroll
            for (int j = 0; j < 4; ++j) { u32x2 w; w.x = cvt_pk_bf16(v[j][0], v[j][1]); w.y = cvt_pk_bf16(v[j][2], v[j][3]); st8b_wt(xb, (unsigned)(m * D + 256 * j + 4 * lane) * 2u, w); }
            if (lane == 0) __hip_atomic_store((unsigned*)(rsa + m), __float_as_uint(1.0f / sqrtf(ss * (1.0f / D) + EPS)), __ATOMIC_RELAXED, __HIP_MEMORY_SCOPE_AGENT); }
        dep_done_wt(cnt_ptr(P.ws, 0, C_X) + 64 * (it >> 3), tid, 2u);
    }
}
__device__ __forceinline__ void phase_res(Ptrs& P, const float* g, float* rs_out, const unsigned char* fptr, const size_t fblk, const unsigned* cwait, unsigned* cdone, unsigned* tmo, const bool final_out, unsigned* ticket, LAS unsigned char* lds, int tid, int wave, int lane) {
    float* yo = P.out + OUT_X; bf16_t* xb = (bf16_t*)(P.ws + WS_XB);
    f32x4 gv[4];
#pragma unroll
    for (int j = 0; j < 4; ++j) gv[j] = *(const f32x4*)(g + 256 * j + 4 * lane);
    volatile LAS unsigned* slot = (volatile LAS unsigned*)(lds + 131072 + 1024);
    int it = claim_bcast(tid == 0 ? __hip_atomic_fetch_add(ticket, 1u, __ATOMIC_RELAXED, __HIP_MEMORY_SCOPE_AGENT) : 0u, slot, tid);
    while (it < NPANEL * 8) {
        unsigned nx = 0u; if (tid == 0) nx = __hip_atomic_fetch_add(ticket, 1u, __ATOMIC_RELAXED, __HIP_MEMORY_SCOPE_AGENT);
        const int pm = it >> 3;
        dep_wait(cwait + 64 * pm, 32u, tmo, tid);
        const bf16_t* fb = (const bf16_t*)(fptr + (size_t)pm * fblk);
        for (int i = 0; i < 4; ++i) { const int lr = (it & 7) * 32 + wave * 4 + i, m = pm * BM + lr;
            f32x4 fv[4], xv[4]; float ss = 0.f;
#pragma unroll
            for (int j = 0; j < 4; ++j) { const u32x2 fw = *(const u32x2*)(fb + (size_t)lr * D + 256 * j + 4 * lane); fv[j] = (f32x4){bf_lo(fw.x), bf_hi(fw.x), bf_lo(fw.y), bf_hi(fw.y)};
                const u32x2 xw = *(const u32x2*)(xb + (size_t)m * D + 256 * j + 4 * lane); xv[j] = (f32x4){bf_lo(xw.x), bf_hi(xw.x), bf_lo(xw.y), bf_hi(xw.y)};
                ss += (fv[j][0] * fv[j][0] + fv[j][1] * fv[j][1]) + (fv[j][2] * fv[j][2] + fv[j][3] * fv[j][3]); }
            const float c = 1.0f / sqrtf(wave_sum(ss, lane) * (1.0f / D) + EPS); float s2 = 0.f;
#pragma unroll
            for (int j = 0; j < 4; ++j) { xv[j] = xv[j] + fv[j] * c * gv[j]; s2 += (xv[j][0] * xv[j][0] + xv[j][1] * xv[j][1]) + (xv[j][2] * xv[j][2] + xv[j][3] * xv[j][3]); }
            if (final_out) {
#pragma unroll
                for (int j = 0; j < 4; ++j) *(f32x4*)(yo + (size_t)m * D + 256 * j + 4 * lane) = xv[j];
            } else {
                s2 = wave_sum(s2, lane);
#pragma unroll
                for (int j = 0; j < 4; ++j) { u32x2 w; w.x = cvt_pk_bf16(xv[j][0], xv[j][1]); w.y = cvt_pk_bf16(xv[j][2], xv[j][3]); st8b_wt(xb, (unsigned)(m * D + 256 * j + 4 * lane) * 2u, w); }
                if (lane == 0) __hip_atomic_store((unsigned*)(rs_out + m), __float_as_uint(1.0f / sqrtf(s2 * (1.0f / D) + EPS)), __ATOMIC_RELAXED, __HIP_MEMORY_SCOPE_AGENT); } }
        if (cdone) dep_done_wt(cdone + 64 * pm, tid, 2u);
        it = claim_bcast(nx, slot, tid);
    }
}

constexpr int VT_LD = 136;
__device__ __forceinline__ void sgu_item(Ptrs& P, int l, int item, LAS unsigned char* lds, int tid, int wave, int lane) {
    const int chunk = item >> 3, h = item & 7, row0 = chunk * 128, pm = chunk >> 1, lr0 = (chunk & 1) * 128; const bool is_sample = chunk >= 128;
    const int fr = lane & 15, fq = lane >> 4;
    LAS float* st = (LAS float*)lds;
    LAS bf16_t* VT = (LAS bf16_t*)(lds + 1024);
    const float* lnpart = (const float*)(P.ws + WS_LNP);
    const bf16_t* ub = (const bf16_t*)(P.ws + WS_BIG + (size_t)pm * BIG_BLK) + (size_t)lr0 * D; const bf16_t* gvb = ub + SEG_B / 2;
    const bf16_t* wsp = (const bf16_t*)(P.ws + (size_t)(l & 1) * WBLK + WOFF_SP);
    bf16_t* dyb = (bf16_t*)(P.ws + WS_DY + (size_t)pm * DY_BLK) + (size_t)lr0 * KAB;
    const float* lng = P.in[8] + (size_t)l * D; const float* lnb = P.in[9] + (size_t)l * D; const float* bsp = P.in[7] + (size_t)l * 8 * 128;
    const int w = wave, k1 = w >> 1, k0 = is_sample ? k1 : 0;
    bf16x8 af[4];
#pragma unroll
    for (int k = 0; k < 4; ++k) { af[k] = (bf16x8){0, 0, 0, 0, 0, 0, 0, 0};
        if (!is_sample) { if (k <= k1) af[k] = *(const bf16x8*)(wsp + ((size_t)(h * 128 + 16 * w + fr)) * 128 + 32 * k + 8 * fq); }
        else if (k == k1 && fq == 2 * (w & 1) + (fr >> 3)) af[k] = *(const bf16x8*)(wsp + ((size_t)(h * 128 + (fr & 7))) * 128); }
    const int tl = 16 * w + fr; const float bias = bsp[h * 128 + (is_sample ? (fr & 7) : tl)];
    u32x2 uu[8];
#pragma unroll
    for (int n = 0; n < 8; ++n) uu[n] = *(const u32x2*)(ub + (size_t)tl * D + h * 128 + 16 * n + 4 * fq);
    u32x4 gr0[2], gr1[2]; f32x4 lga[2], lgb[2], lba[2], lbb[2];
#pragma unroll
    for (int it = 0; it < 2; ++it) { const int idx = tid + it * 512, p = idx & 63, cg8 = idx >> 6, s = 2 * p, col = h * 128 + cg8 * 8;
        gr0[it] = *(const u32x4*)(gvb + (size_t)s * D + col); gr1[it] = *(const u32x4*)(gvb + (size_t)(s + 1) * D + col);
        lga[it] = *(const f32x4*)(lng + col); lgb[it] = *(const f32x4*)(lng + col + 4); lba[it] = *(const f32x4*)(lnb + col); lbb[it] = *(const f32x4*)(lnb + col + 4); }
    if (tid < 128) { const float* p = lnpart + (size_t)(row0 + tid) * 32; float s1 = 0.f, s2 = 0.f;
#pragma unroll
        for (int j = 0; j < 8; ++j) { const f32x4 q = *(const f32x4*)(p + 4 * j); s1 += q[0] + q[2]; s2 += q[1] + q[3]; }
        const float mean = s1 * (1.0f / D), var = fmaxf(s2 * (1.0f / D) - mean * mean, 0.f);
        st[2 * tid] = mean; st[2 * tid + 1] = 1.0f / sqrtf(var + EPS); }
    __syncthreads();
#pragma unroll
    for (int it = 0; it < 2; ++it) { const int idx = tid + it * 512, p = idx & 63, cg8 = idx >> 6, s = 2 * p, col = h * 128 + cg8 * 8;
        const u32x4 r0 = gr0[it], r1 = gr1[it];
        const f32x4 ga = lga[it], gb = lgb[it], ba = lba[it], bb = lbb[it];
        const float m0 = st[2 * s], q0 = st[2 * s + 1], m1 = st[2 * s + 2], q1 = st[2 * s + 3];
        float a0[8] = {bf_lo(r0.x), bf_hi(r0.x), bf_lo(r0.y), bf_hi(r0.y), bf_lo(r0.z), bf_hi(r0.z), bf_lo(r0.w), bf_hi(r0.w)};
        float a1[8] = {bf_lo(r1.x), bf_hi(r1.x), bf_lo(r1.y), bf_hi(r1.y), bf_lo(r1.z), bf_hi(r1.z), bf_lo(r1.w), bf_hi(r1.w)};
        const float gg[8] = {ga[0], ga[1], ga[2], ga[3], gb[0], gb[1], gb[2], gb[3]}, bq[8] = {ba[0], ba[1], ba[2], ba[3], bb[0], bb[1], bb[2], bb[3]};
#pragma unroll
        for (int j = 0; j < 8; ++j) { a0[j] = (a0[j] - m0) * q0 * gg[j] + bq[j]; a1[j] = (a1[j] - m1) * q1 * gg[j] + bq[j]; }
        if (is_sample) { float* vo = P.out + OUT_VS + ((size_t)l * MS + (row0 - MP) + s) * D + col;
            *(f32x4*)(vo) = (f32x4){a0[0], a0[1], a0[2], a0[3]}; *(f32x4*)(vo + 4) = (f32x4){a0[4], a0[5], a0[6], a0[7]};
            *(f32x4*)(vo + D) = (f32x4){a1[0], a1[1], a1[2], a1[3]}; *(f32x4*)(vo + D + 4) = (f32x4){a1[4], a1[5], a1[6], a1[7]}; }
#pragma unroll
        for (int j = 0; j < 8; ++j) *(LAS unsigned*)(VT + (cg8 * 8 + j) * VT_LD + s) = cvt_pk_bf16(a0[j], a1[j]);
    }
    __syncthreads();
    f32x4 acc[8];
#pragma unroll
    for (int n = 0; n < 8; ++n) acc[n] = (f32x4){0.f, 0.f, 0.f, 0.f};
#pragma unroll
    for (int k = 0; k < 4; ++k) { if (k >= k0 && k <= k1) {
#pragma unroll
        for (int n = 0; n < 8; ++n) { const bf16x8 bfr = *(const LAS bf16x8*)(VT + (16 * n + fr) * VT_LD + 32 * k + 8 * fq);
            acc[n] = __builtin_amdgcn_mfma_f32_16x16x32_bf16(bfr, af[k], acc[n], 0, 0, 0); } } }
#pragma unroll
    for (int n = 0; n < 8; ++n) { const int col = h * 128 + 16 * n + 4 * fq;
        const float y0 = bf_lo(uu[n].x) * (acc[n][0] + bias), y1 = bf_hi(uu[n].x) * (acc[n][1] + bias), y2 = bf_lo(uu[n].y) * (acc[n][2] + bias), y3 = bf_hi(uu[n].y) * (acc[n][3] + bias);
        u32x2 o; o.x = cvt_pk_bf16(y0, y1); o.y = cvt_pk_bf16(y2, y3); st8b_wt(dyb, (unsigned)(tl * KAB + 512 + col) * 2u, o); }
}
__device__ __forceinline__ f32x4 ld_a(const unsigned char* ws, int gr, int ch) {
    const u32x2 w = *(const u32x2*)((const bf16_t*)(ws + WS_AF + (size_t)(gr >> 8) * AF_BLK) + (size_t)(gr & 255) * WA + ch);
    return (f32x4){bf_lo(w.x), bf_hi(w.x), bf_lo(w.y), bf_hi(w.y)};
}
template <int W>
__device__ __forceinline__ void pool_w(Ptrs& P, int l, int chunk, int g, int tid) {
    const int cq = tid & 31, rs = tid >> 5, ch = g * 128 + cq * 4;
    const unsigned char* ws = P.ws;
    f32x4 rows[W + 7];
    if (chunk < 128) {
        const int rb = chunk * 128, t0 = (chunk & 15) * 128, tl0 = rs * 8;
        bf16_t* dyb = (bf16_t*)(P.ws + WS_DY + (size_t)(chunk >> 1) * DY_BLK) + (size_t)((chunk & 1) * 128) * KAB;
#pragma unroll
        for (int k = 0; k < W + 7; ++k) { const int tl = tl0 - (W - 1) + k; rows[k] = (t0 + tl >= 0) ? ld_a(ws, rb + tl, ch) : (f32x4){0.f, 0.f, 0.f, 0.f}; }
        f32x4 S = (f32x4){0.f, 0.f, 0.f, 0.f};
#pragma unroll
        for (int k = 0; k < W - 1; ++k) S = S + rows[k];
#pragma unroll
        for (int i = 0; i < 8; ++i) { const int tl = tl0 + i, pos = t0 + tl; const f32x4 cur = rows[W - 1 + i];
            S = S + cur; const float inv = 1.0f / (float)(pos + 1 < W ? pos + 1 : W); const f32x4 d = S * inv - cur;
            u32x2 o; o.x = cvt_pk_bf16(d[0], d[1]); o.y = cvt_pk_bf16(d[2], d[3]); st8b_wt(dyb, (unsigned)(tl * KAB + ch) * 2u, o);
            if ((chunk & 15) == 15 && tl >= 113) *(f32x4*)(P.out + OUT_PP + (((size_t)l * 8 + (chunk >> 4)) * 15 + (tl - 113)) * WA + ch) = cur;
            S = S - rows[i]; }
    } else {
        const int seq = (chunk - 128) * 16 + rs; const float* sp = P.in[2] + ((size_t)l * 128 + seq) * 15 * WA + ch; const int gr0 = MP + seq * 8;
        bf16_t* dyb = (bf16_t*)(P.ws + WS_DY + (size_t)(chunk >> 1) * DY_BLK) + (size_t)((chunk & 1) * 128) * KAB;
        float* po = P.out + OUT_PS + ((size_t)l * 128 + seq) * 15 * WA + ch;
#pragma unroll
        for (int k = 0; k < W + 7; ++k) { const int e = 15 - (W - 1) + k; rows[k] = e < 15 ? *(const f32x4*)(sp + (size_t)e * WA) : ld_a(ws, gr0 + e - 15, ch); }
#pragma unroll
        for (int i = 0; i < 7; ++i) *(f32x4*)(po + (size_t)i * WA) = *(const f32x4*)(sp + (size_t)(8 + i) * WA);
        f32x4 S = (f32x4){0.f, 0.f, 0.f, 0.f};
#pragma unroll
        for (int k = 0; k < W - 1; ++k) S = S + rows[k];
#pragma unroll
        for (int i = 0; i < 8; ++i) { const f32x4 cur = rows[W - 1 + i];
            S = S + cur; const f32x4 d = S * (1.0f / (float)W) - cur;
            u32x2 o; o.x = cvt_pk_bf16(d[0], d[1]); o.y = cvt_pk_bf16(d[2], d[3]); st8b_wt(dyb, (unsigned)((rs * 8 + i) * KAB + ch) * 2u, o);
            *(f32x4*)(po + (size_t)(7 + i) * WA) = cur;
            S = S - rows[i]; }
    }
}
__device__ __forceinline__ void pool_item(Ptrs& P, int l, int item, int tid) {
    const int chunk = item >> 2, g = item & 3;
    if (g == 0) pool_w<2>(P, l, chunk, g, tid); else if (g == 1) pool_w<4>(P, l, chunk, g, tid); else if (g == 2) pool_w<8>(P, l, chunk, g, tid); else pool_w<16>(P, l, chunk, g, tid);
}
__device__ __forceinline__ void phase_mix(Ptrs& P, int l, LAS unsigned char* lds, unsigned* tmo, int tid, int wave, int lane) {
    const unsigned* cw = cnt_ptr(P.ws, l, C_G1); unsigned* ticket = ticket_ptr(P.ws, l, 0);
    volatile LAS unsigned* slot = (volatile LAS unsigned*)(lds + 131072 + 1024);
    int it = claim_bcast(tid == 0 ? __hip_atomic_fetch_add(ticket, 1u, __ATOMIC_RELAXED, __HIP_MEMORY_SCOPE_AGENT) : 0u, slot, tid);
    while (it < NPANEL * 12) {
        unsigned nx = 0u; if (tid == 0) nx = __hip_atomic_fetch_add(ticket, 1u, __ATOMIC_RELAXED, __HIP_MEMORY_SCOPE_AGENT);
        const int pm = it / 12, r = it - pm * 12;
        if (r < 8) { const int chunk = pm * 2 + (r >> 2), h0 = (r & 3) * 2;
            dep_wait(cw + 64 * pm, 144u, tmo, tid);
            sgu_item(P, l, chunk * 8 + h0, lds, tid, wave, lane); __syncthreads(); sgu_item(P, l, chunk * 8 + h0 + 1, lds, tid, wave, lane);
        } else { const int chunk = pm * 2 + ((r - 8) >> 1), g0 = ((r - 8) & 1) * 2;
            if ((chunk & 1) == 0 && chunk < 128 && (chunk & 15) != 0) dep_wait2(cw + 64 * pm, cw + 64 * (pm - 1), 144u, tmo, tid); else dep_wait(cw + 64 * pm, 144u, tmo, tid);
            pool_item(P, l, chunk * 4 + g0, tid); pool_item(P, l, chunk * 4 + g0 + 1, tid); }
        dep_done_wt(cnt_ptr(P.ws, l, C_MIX) + 64 * pm, tid, 2u);
        it = claim_bcast(nx, slot, tid);
    }
}
}

__global__ void __launch_bounds__(512, 2) mk_fwd(Params prm) {
    extern __shared__ __attribute__((aligned(16))) unsigned char lds_raw[];
    LAS unsigned char* lds = (LAS unsigned char*)lds_raw;
    cg::grid_group grid = cg::this_grid();
    volatile LAS unsigned* bst = (volatile LAS unsigned*)(lds + 131072 + 512);
    if (threadIdx.x < 2) bst[threadIdx.x] = 0u;
    __syncthreads();
    (void)xcd_barrier_post((unsigned*)(prm.ws + WS_BAR), bst);
    if (prm.ph_hi < 0) grid.sync();
    constexpr int nM = M / BM;
    const int wave = __builtin_amdgcn_readfirstlane(threadIdx.x >> 6);
    constexpr size_t TS1K = (size_t)BM * D * 2;
    {
        const int lane = launder_v(lane_id()), tid = wave * 64 + lane;
        Ptrs& P = *kargs();
        phase_r0(P, tid, wave, lane); prep_layer(P, 0, lds, wave, lane, blockIdx.x, gridDim.x);
        xcd_barrier((unsigned*)(P.ws + WS_BAR), (volatile LAS unsigned*)(lds + 131072 + 512), tid);
    }
    for (int l = 0; l < DEPTH; ++l) {
        for (int s = 0; s < 9; ++s) {
            const int lane = launder_v(lane_id()), tid = wave * 64 + lane;
            Ptrs& P = *kargs(); unsigned char* ws = P.ws; unsigned char* wb = ws + (size_t)(l & 1) * WBLK;
            unsigned* tmo = (unsigned*)(ws + WS_BAR) + XB_TMO;
            const unsigned* prepc = cnt_ptr(ws, 5, 0) + 64 * l;
            Dep dp{cnt_ptr(ws, l, 0), tmo, l >= 1 ? cnt_ptr(ws, l - 1, C_MIX) : prepc, prepc, l >= 1 ? (gridDim.x == 256 ? 208u : gridDim.x) : 0u};
            if (s == 0 && ((MK_SMASK >> 0) & 1)) {
                EpiIn E{ws};
                gemm_phase<0, 0, C_X, 16, C_G1, EpiIn>(wave, lds, (const bf16_t*)(ws + WS_XB), TS1K, (const bf16_t*)(wb + WOFF_IN), D, nM, DIN / BM, E, dp);
            } else if (s == 2 && ((MK_SMASK >> 2) & 1)) {
                phase_mix(P, l, lds, tmo, tid, wave, lane);
            } else if (s == 3 && ((MK_SMASK >> 3) & 1)) {
                EpiAB E{ws, (unsigned char*)P.out + OUT_MSCR};
                gemm_phase<1, 3, C_MIX, 24, C_G2, EpiAB>(wave, lds, (const bf16_t*)(ws + WS_DY), DY_BLK, (const bf16_t*)(wb + WOFF_AB), KAB, nM, D / BM, E, dp);
            } else if (s == 4 && ((MK_SMASK >> 4) & 1)) {
                EpiF E{(unsigned char*)P.out, AF_BLK};
                gemm_phase<0, 4, C_G2, 32, C_G3, EpiF>(wave, lds, (const bf16_t*)((unsigned char*)P.out + OUT_MSCR), TS1K, (const bf16_t*)(wb + WOFF_OUT), D, nM, D / BM, E, dp);
                if (l + 1 < DEPTH) {
                    const int c = blockIdx.x, v = (c & 7) * 32 + (c >> 3), h = v >> 4, p = v - h - 1; const bool sub = gridDim.x == 256;
                    if (!sub || ((v & 15) != 0 && p >= 32)) {
                        if (l >= 1) dep_wait_many(cnt_ptr(ws, l - 1, C_G5), NPANEL, 32u, tmo, tid, [](int i) { return i; });
                        if (sub) prep_layer(P, l + 1, lds, wave, lane, p - 32, 208); else prep_layer(P, l + 1, lds, wave, lane, blockIdx.x, gridDim.x);
                        dep_done_wt(cnt_ptr(ws, 5, 0) + 64 * (l + 1), tid); }
                }
            } else if (s == 5 && ((MK_SMASK >> 5) & 1)) {
                phase_res(P, P.in[16] + (size_t)l * D, (float*)(ws + WS_RSB), (const unsigned char*)P.out, AF_BLK, cnt_ptr(ws, l, C_G3), cnt_ptr(ws, l, C_R1), tmo, false, ticket_ptr(ws, l, 1), lds, tid, wave, lane);
                if (l + 1 == DEPTH) xcd_barrier((unsigned*)(ws + WS_BAR), (volatile LAS unsigned*)(lds + 131072 + 512), tid);
            } else if (s == 6 && ((MK_SMASK >> 6) & 1)) {
                EpiUp E{ws};
                gemm_phase<0, 1, C_R1, 16, C_G4, EpiUp>(wave, lds, (const bf16_t*)(ws + WS_XB), TS1K, (const bf16_t*)(wb + WOFF_UP), D, nM, DFF / BM, E, dp);
            } else if (s == 7 && ((MK_SMASK >> 7) & 1)) {
                EpiF E{ws + WS_DY, DY_BLK};
                gemm_phase<0, 2, C_G4, 128, C_G5, EpiF>(wave, lds, (const bf16_t*)(ws + WS_BIG), BIG_BLK, (const bf16_t*)(wb + WOFF_DN), DFF, nM, D / BM, E, dp);
            } else if (s == 8 && ((MK_SMASK >> 8) & 1)) {
                phase_res(P, P.in[18] + (size_t)l * D, (float*)(ws + WS_RSA), ws + WS_DY, DY_BLK, cnt_ptr(ws, l, C_G5), l + 1 < DEPTH ? cnt_ptr(ws, l + 1, C_X) : nullptr, tmo, l + 1 == DEPTH, ticket_ptr(ws, l, 2), lds, tid, wave, lane);
            }
            __syncthreads();
        }
    }
}

extern "C" void kernel_launch(void* const* d_in, const int* in_sizes, int n_in, void* d_out, int out_size, void* d_ws, size_t ws_size, hipStream_t stream) {
    static int grid = 0;
    if (grid == 0) {
        if (n_in != 19 || in_sizes[0] != MP * D || in_sizes[1] != MS * D || ws_size < WS_END || (size_t)out_size != OUT_VS + (size_t)DEPTH * MS * D) {
            fprintf(stderr, "kernel_launch: unexpected shapes / workspace (n_in %d, ws %zu, out %d); nothing launched\n", n_in, ws_size, out_size); grid = -1; return; }
        int dev = 0, cus = 0, per_cu = 0;
        if (hipGetDevice(&dev) != hipSuccess || hipDeviceGetAttribute(&cus, hipDeviceAttributeMultiprocessorCount, dev) != hipSuccess) { grid = -1; return; }
        if (hipFuncSetAttribute((const void*)mk_fwd, hipFuncAttributeMaxDynamicSharedMemorySize, LDS_BYTES) != hipSuccess) { fprintf(stderr, "kernel_launch: hipFuncSetAttribute failed\n"); grid = -1; return; }
        if (hipOccupancyMaxActiveBlocksPerMultiprocessor(&per_cu, (const void*)mk_fwd, 512, LDS_BYTES) != hipSuccess || per_cu < 1) { fprintf(stderr, "kernel_launch: occupancy query says %d\n", per_cu); per_cu = 1; }
        (void)hipGetLastError();
        grid = cus * 1;
    }
    if (grid < 0) return;
    if (hipMemsetAsync((char*)d_ws + WS_BAR, 0, CTL_BYTES, stream) != hipSuccess) { fprintf(stderr, "kernel_launch: memset failed\n"); return; }
    Params a{};
    for (int i = 0; i < 19; ++i) a.in[i] = (const float*)d_in[i];
    a.out = (float*)d_out; a.ws = (unsigned char*)d_ws;
    a.ph_lo = 0; a.ph_hi = 1;
    void* args[] = {&a};
    hipError_t e = hipLaunchCooperativeKernel((const void*)mk_fwd, dim3(grid), dim3(512), args, LDS_BYTES, stream);
    if (e != hipSuccess) fprintf(stderr, "cooperative launch failed: %s (grid %d)\n", hipGetErrorString(e), grid);
}
```

```cpp
#include <hip/hip_runtime.h>
#include <hip/hip_cooperative_groups.h>
#include <cstdio>
namespace cg = cooperative_groups;

#ifndef MK_NOHOOK
#define MK_NOHOOK 0
#endif
#ifndef MK_SMASK
#define MK_SMASK 511
#endif
#define LAS __attribute__((address_space(3)))
typedef unsigned short bf16_t;
typedef short bf16x8 __attribute__((ext_vector_type(8)));
typedef float f32x4 __attribute__((ext_vector_type(4)));
typedef float f32x2 __attribute__((ext_vector_type(2)));
typedef unsigned u32x4 __attribute__((ext_vector_type(4)));
typedef unsigned u32x2 __attribute__((ext_vector_type(2)));

namespace {
constexpr int MP = 16384, MS = 1024, M = MP + MS;
constexpr int D = 1024, DIN = 4608, DFF = 4096, DEPTH = 4, WA = 512;
constexpr int KAB = 1536;
constexpr float EPS = 1e-6f;
constexpr size_t MiB = 1u << 20;
constexpr size_t WBLK = 31 * MiB;
constexpr size_t WOFF_IN = 0, WOFF_AB = 9 * MiB, WOFF_OUT = 12 * MiB, WOFF_UP = 14 * MiB, WOFF_DN = 22 * MiB, WOFF_SP = 30 * MiB;
constexpr size_t WS_XB = 62 * MiB;
constexpr size_t OUT_MSCR = 34 * MiB;
constexpr size_t WS_BIG = 96 * MiB, BIG_BLK = 2 * MiB;
constexpr size_t SEG_B = 512 * 1024;
constexpr size_t WS_AF = 232 * MiB, AF_BLK = 512 * 1024;
constexpr size_t WS_DY = 266 * MiB, DY_BLK = 768 * 1024;
constexpr size_t WS_RSA = 317 * MiB, WS_RSB = 317 * MiB + 128 * 1024, WS_LNP = 318 * MiB;
constexpr size_t WS_BAR = 321 * MiB, BAR_CNT_OFF = 65536, CTL_BYTES = 1 * MiB, WS_END = 322 * MiB;
enum { C_X = 0, C_G1 = 1, C_MIX = 2, C_G2 = 3, C_G3 = 4, C_R1 = 5, C_G4 = 6, C_G5 = 7 };
constexpr int NPANEL = 68;
constexpr size_t OUT_X = 0, OUT_PP = (size_t)M * D, OUT_PS = OUT_PP + (size_t)DEPTH * 8 * 15 * WA, OUT_VS = OUT_PS + (size_t)DEPTH * 128 * 15 * WA;
constexpr int LDS_BYTES = 147456;

__device__ __forceinline__ unsigned cvt_pk_bf16(float lo, float hi) { unsigned r; asm volatile("v_cvt_pk_bf16_f32 %0, %1, %2" : "=v"(r) : "v"(lo), "v"(hi)); return r; }
template <int OFF> __device__ __forceinline__ void st16_wt(const void* sbase, unsigned voff, u32x4 v) {
    const __amdgpu_buffer_rsrc_t r = __builtin_amdgcn_make_buffer_rsrc((void*)sbase, 0, 0x40000000, 0x00020000); __builtin_amdgcn_raw_buffer_store_b128(v, r, voff + OFF, 0, 16); }
__device__ __forceinline__ void st8b_wt(const void* sbase, unsigned voff, u32x2 v) {
    const __amdgpu_buffer_rsrc_t r = __builtin_amdgcn_make_buffer_rsrc((void*)sbase, 0, 0x40000000, 0x00020000); __builtin_amdgcn_raw_buffer_store_b64(v, r, voff, 0, 16); }
__device__ __forceinline__ void st8_wt(void* p, f32x2 v) { asm volatile("global_store_dwordx2 %0, %1, off sc1" :: "v"(p), "v"(v) : "memory"); }
__device__ __forceinline__ float bf_lo(unsigned w) { return __uint_as_float(w << 16); }
__device__ __forceinline__ float bf_hi(unsigned w) { return __uint_as_float(w & 0xffff0000u); }
__device__ __forceinline__ float sigmoidf_(float x) { return __builtin_amdgcn_rcpf(1.0f + __builtin_amdgcn_exp2f(-1.44269504f * x)); }
__device__ __forceinline__ float gelu_tanh(float x) { const float y = 1.5957691216f * (x + 0.044715f * x * x * x); return x * sigmoidf_(y); }
__device__ __forceinline__ int lane_id() { int x; asm volatile("v_mbcnt_lo_u32_b32 %0, -1, 0\n\tv_mbcnt_hi_u32_b32 %0, -1, %0" : "=v"(x)); return x; }
__device__ __forceinline__ int launder_v(int x) { asm volatile("" : "+v"(x)); return x; }
__device__ __forceinline__ float shfl_xor_l(float v, int o, int lane) { return __int_as_float(__builtin_amdgcn_ds_bpermute(4 * (lane ^ o), __float_as_int(v))); }
__device__ __forceinline__ float wave_sum(float v, int lane) {
#pragma unroll
    for (int o = 1; o < 64; o <<= 1) v += shfl_xor_l(v, o, lane);
    return v;
}


#define XB_TMO      128
#define XB_XCNT(j)  (256  + 64 * (j))
#define XB_XSUB(j)  (1280 + 64 * (j))
#define XB_XGEN(j)  (2304 + 64 * (j))
#define XB_TOP      3328
#define XB_TOPGEN   3392
#define XCD_BAR_WORDS 3456
#define XB_SPIN_CAP (1u << 19)
__device__ __forceinline__ unsigned xb_ld(unsigned* p)              { return __hip_atomic_load(p, __ATOMIC_RELAXED, __HIP_MEMORY_SCOPE_AGENT); }
__device__ __forceinline__ unsigned xb_add(unsigned* p, unsigned v) { return __hip_atomic_fetch_add(p, v, __ATOMIC_RELAXED, __HIP_MEMORY_SCOPE_AGENT); }
__device__ __forceinline__ unsigned xb_xcc_id() { return (unsigned)__builtin_amdgcn_s_getreg((3 << 11) | 20) & 0xFu; }
#define XB_SPIN(cond, bar) do { unsigned _sp = 0; while (cond) { __builtin_amdgcn_s_sleep(1); \
    if ((++_sp & 255u) == 0u) { if (xb_ld(&(bar)[XB_TMO])) break; if (_sp > XB_SPIN_CAP) { atomicAdd(&(bar)[XB_TMO], 1u); break; } } } } while (0)
struct XcdBarrier { unsigned* bar; unsigned x; volatile LAS unsigned* st; };
__device__ __forceinline__ XcdBarrier xcd_barrier_post(unsigned* bar, volatile LAS unsigned* st) {
    XcdBarrier b; b.bar = bar; b.x = xb_xcc_id(); b.st = st;
    if (threadIdx.x == 0) (void)xb_add(&bar[XB_XCNT(b.x)], 1u);
    return b;
}
__device__ __forceinline__ void xcd_barrier_complete(unsigned* bar, unsigned x, unsigned& nloc, unsigned& nx) {
    const unsigned G = gridDim.x * gridDim.y * gridDim.z;
    unsigned sum, cnt, mine, sp = 0u;
    for (;;) {
        sum = 0u; cnt = 0u; mine = 0u;
#pragma unroll
        for (unsigned j = 0; j < 16; ++j) { const unsigned c = xb_ld(&bar[XB_XCNT(j)]); sum += c; cnt += (c > 0u) ? 1u : 0u; mine = (j == x) ? c : mine; }
        if (sum == G) break;
        __builtin_amdgcn_s_sleep(1);
        if ((++sp & 255u) == 0u) { if (xb_ld(&bar[XB_TMO])) break; if (sp > XB_SPIN_CAP) { atomicAdd(&bar[XB_TMO], 1u); break; } }
    }
    nloc = mine > 0u ? mine : 1u; nx = cnt > 0u ? cnt : 1u;
}
__device__ __forceinline__ void xcd_barrier(unsigned* bar_, volatile LAS unsigned* st_, int tid) {
    XcdBarrier b; b.bar = bar_; b.x = xb_xcc_id(); b.st = st_;
    asm volatile("s_waitcnt vmcnt(0)" ::: "memory");
    __syncthreads();
    if (tid == 0) {
        unsigned* bar = b.bar;
        __builtin_amdgcn_s_waitcnt(0);
        unsigned nloc = b.st[0], nx = b.st[1];
        if (nloc == 0u) { xcd_barrier_complete(bar, b.x, nloc, nx); b.st[0] = nloc; b.st[1] = nx; }
        const unsigned old = xb_add(&bar[XB_XSUB(b.x)], 1u);
        const unsigned gen = old / nloc;
        if (old + 1u == (gen + 1u) * nloc) {
            __builtin_amdgcn_fence(__ATOMIC_RELEASE, "agent");
            asm volatile("s_waitcnt vmcnt(0)" ::: "memory");
            const unsigned og = xb_add(&bar[XB_TOP], 1u);
            const unsigned tg = og / nx;
            if (og + 1u == (tg + 1u) * nx) xb_add(&bar[XB_TOPGEN], 1u);
            else XB_SPIN(xb_ld(&bar[XB_TOPGEN]) == tg, bar);
            __builtin_amdgcn_fence(__ATOMIC_ACQUIRE, "agent");
            xb_add(&bar[XB_XGEN(b.x)], 1u);
            asm volatile("s_waitcnt vmcnt(0)" ::: "memory");
        } else {
            XB_SPIN(xb_ld(&bar[XB_XGEN(b.x)]) == gen, bar);
            __builtin_amdgcn_fence(__ATOMIC_ACQUIRE, "agent");
            asm volatile("s_waitcnt vmcnt(0)" ::: "memory");
        }
    }
    __syncthreads();
}

struct Dep { unsigned* cl; unsigned* tmo; const unsigned* prevmix; const unsigned* prep; unsigned nprep; };
__device__ __forceinline__ unsigned* cnt_ptr(unsigned char* ws, int l, int stage) { return (unsigned*)(ws + WS_BAR + BAR_CNT_OFF) + (size_t)((l * 8 + stage) * NPANEL) * 64; }
__device__ __forceinline__ void dep_wait1(const unsigned* w, unsigned need, unsigned* tmo, int tid) {
    unsigned polls = 0;
    while ((unsigned)__builtin_amdgcn_readfirstlane(__hip_atomic_load(w, __ATOMIC_RELAXED, __HIP_MEMORY_SCOPE_AGENT)) < need) {
        if ((++polls & 255u) == 0u) { if (__builtin_amdgcn_readfirstlane(__hip_atomic_load(tmo, __ATOMIC_RELAXED, __HIP_MEMORY_SCOPE_AGENT)) != 0u) break;
            if (polls > (1u << 17)) { if (tid == 0) __hip_atomic_store(tmo, 1u, __ATOMIC_RELAXED, __HIP_MEMORY_SCOPE_AGENT); break; } }
        __builtin_amdgcn_s_sleep(2); }
}
__device__ __forceinline__ void dep_wait(const unsigned* w, unsigned need, unsigned* tmo, int tid) {
    if (tid < 64) { dep_wait1(w, need, tmo, tid); __builtin_amdgcn_fence(__ATOMIC_ACQUIRE, "agent"); asm volatile("s_waitcnt vmcnt(0)" ::: "memory"); }
    asm volatile("" ::: "memory"); __builtin_amdgcn_s_barrier(); asm volatile("" ::: "memory");
}
__device__ __forceinline__ void dep_wait2(const unsigned* w0, const unsigned* w1, unsigned need, unsigned* tmo, int tid) {
    if (tid < 64) { dep_wait1(w0, need, tmo, tid); dep_wait1(w1, need, tmo, tid); __builtin_amdgcn_fence(__ATOMIC_ACQUIRE, "agent"); asm volatile("s_waitcnt vmcnt(0)" ::: "memory"); }
    asm volatile("" ::: "memory"); __builtin_amdgcn_s_barrier(); asm volatile("" ::: "memory");
}
template <class Sel>
__device__ __forceinline__ void dep_wait_many(const unsigned* cbase, int n, unsigned need, unsigned* tmo, int tid, const Sel& sel) {
    if (tid < 64) { unsigned polls = 0;
        for (;;) { const unsigned a = tid < n ? __hip_atomic_load(cbase + 64 * sel(tid), __ATOMIC_RELAXED, __HIP_MEMORY_SCOPE_AGENT) : need;
            const unsigned b = tid + 64 < n ? __hip_atomic_load(cbase + 64 * sel(tid + 64), __ATOMIC_RELAXED, __HIP_MEMORY_SCOPE_AGENT) : need;
            if (__all(a >= need && b >= need)) break;
            if ((++polls & 255u) == 0u) { if (__builtin_amdgcn_readfirstlane(__hip_atomic_load(tmo, __ATOMIC_RELAXED, __HIP_MEMORY_SCOPE_AGENT)) != 0u) break;
                if (polls > (1u << 17)) { if (tid == 0) __hip_atomic_store(tmo, 1u, __ATOMIC_RELAXED, __HIP_MEMORY_SCOPE_AGENT); break; } }
            __builtin_amdgcn_s_sleep(2); }
        __builtin_amdgcn_fence(__ATOMIC_ACQUIRE, "agent"); asm volatile("s_waitcnt vmcnt(0)" ::: "memory"); }
    asm volatile("" ::: "memory"); __builtin_amdgcn_s_barrier(); asm volatile("" ::: "memory");
}
__device__ __forceinline__ void dep_wait3(const unsigned* w0, unsigned n0, const unsigned* w1, unsigned n1, const unsigned* w2, unsigned n2, unsigned* tmo, int tid) {
    if (tid < 64) { dep_wait1(w0, n0, tmo, tid); dep_wait1(w1, n1, tmo, tid); dep_wait1(w2, n2, tmo, tid); __builtin_amdgcn_fence(__ATOMIC_ACQUIRE, "agent"); asm volatile("s_waitcnt vmcnt(0)" ::: "memory"); }
    asm volatile("" ::: "memory"); __builtin_amdgcn_s_barrier(); asm volatile("" ::: "memory");
}
__device__ __forceinline__ void dep_done_wt(unsigned* c, int tid, unsigned inc = 1u) {
    asm volatile("s_waitcnt vmcnt(0)" ::: "memory"); __builtin_amdgcn_s_barrier(); asm volatile("" ::: "memory");
    if (tid == 0) __hip_atomic_fetch_add(c, inc, __ATOMIC_RELAXED, __HIP_MEMORY_SCOPE_AGENT);
}
__device__ __forceinline__ void dep_done(unsigned* c, int tid) {
    asm volatile("s_waitcnt vmcnt(0)" ::: "memory"); __builtin_amdgcn_s_barrier(); asm volatile("" ::: "memory");
    if (tid == 0) { __builtin_amdgcn_fence(__ATOMIC_RELEASE, "agent"); asm volatile("s_waitcnt vmcnt(0)" ::: "memory"); __hip_atomic_fetch_add(c, 1u, __ATOMIC_RELAXED, __HIP_MEMORY_SCOPE_AGENT); }
}

constexpr int BM = 256, BK = 64, HALF = 128, HTB = HALF * BK * 2, NXCD = 8, WGM = 8;
__device__ __forceinline__ int lds_byte(int r, int c) { const int st = (r >> 4) * 2 + (c >> 5), rr = r & 15, cc = c & 31, ob = rr * 64 + cc * 2; return st * 1024 + (ob ^ (((ob >> 9) & 1) << 5)); }
__device__ __forceinline__ void stage_rc(int b, int& R, int& C) { const int st = b / 1024, sb = b % 1024, swz = sb ^ (((sb >> 9) & 1) << 5); R = (st >> 1) * 16 + swz / 64; C = (st & 1) * 32 + (swz % 64) / 2; }
__device__ __forceinline__ int perm32(int rho) { const int n = rho >> 4, i = rho & 15; return 8 * (i >> 2) + 4 * n + (i & 3); }

struct Unit { int pm, pn, sub; };
__device__ __forceinline__ bool tile_of(long L, int nM, int nN, int& pm, int& pn) {
    const int nwg = nM * nN; if (L >= nwg) return false;
    int wgid = (int)L; { const int q = nwg / NXCD, r = nwg % NXCD, xcd = wgid % NXCD, off = wgid / NXCD; wgid = (xcd < r ? xcd * (q + 1) : r * (q + 1) + (xcd - r) * q) + off; }
    const int nig = WGM * nN, gid = wgid / nig, fm = gid * WGM, gsz = (nM - fm) < WGM ? (nM - fm) : WGM;
    pm = fm + ((wgid % nig) % gsz); pn = (wgid % nig) / gsz; return true;
}
template <int MODE, int SCHED>
__device__ __forceinline__ bool get_unit(int i, int G, int c, int nM, int nN, int NT, Unit& u, int& kofs, int& nt) {
    const int round = MODE == 1 ? (i >> 1) : i;
    if (MODE == 1) { u.sub = i & 1; kofs = u.sub * 512; nt = u.sub ? 16 : 8; } else { u.sub = 0; kofs = 0; nt = NT; }
    if (SCHED == 0 || G != 256) return tile_of((long)round * G + c, nM, nN, u.pm, u.pn);
    const int v = (c & 7) * 32 + (c >> 3), h = v >> 4, p = v - h - 1; const bool heavy = (v & 15) == 0;
    if (SCHED == 7) {
        const int x = v >> 5, w32 = v & 31, pos = round * 32 + w32; if (pos >= 153) return false;
        if (pos >= 144) { const int e = x * 9 + (pos - 144); u.pm = 64 + e / 18; u.pn = e % 18; }
        else { const int b = pos / 36, i = pos - 36 * b; u.pn = i >> 1; u.pm = x + 16 * b + 8 * (i & 1); }
        return true;
    }
    if (SCHED == 1) {
        if (heavy) return false;
        const int x = p / 30, q = p - 30 * x, tl = round * 30 + q; if (tl >= 136) return false;
        u.pm = tl >> 1; u.pn = 2 * x + (tl & 1); return true;
    } else if (SCHED == 2) {
        int j;
        if (heavy) { if (round >= 2) return false; j = h * 2 + round; }
        else { if (round >= 1) return false; const int x = p / 30, q = p - 30 * x; j = (q >= 16) ? 32 + x * 14 + (q - 16) : 144 + x * 16 + q; }
        u.pm = j >> 2; u.pn = j & 3; return true;
    } else if (SCHED == 3) {
        int j;
        if (heavy) { if (round >= 2) return false; j = 240 + round * 16 + h; } else { if (round >= 1) return false; j = p; }
        u.pm = j >> 2; u.pn = j & 3; return true;
    } else {
        if (heavy) return false;
        int j;
        if (round == 0) j = p; else if (round == 1 && p < 32) j = 240 + p; else return false;
        u.pm = j >> 2; u.pn = j & 3; return true;
    }
}

template <int MODE, int SCHED, int WST, int NEED, int DST, class Epi>
__device__ __forceinline__ void gemm_phase(const int wid_, LAS unsigned char* lds, const bf16_t* Ab, const size_t tstepA, const bf16_t* Bb, const int ld, const int nM, const int nN, const Epi& E, const Dep& dep) {
    const int wid = wid_, lane = launder_v(lane_id()), tid = wid * 64 + lane, wr = wid >> 2, wc = wid & 3, fr = lane & 15, fq = lane >> 4;
    const int G = gridDim.x, c = blockIdx.x;
    unsigned voffA[2], voffB[2];
#pragma unroll
    for (int i = 0; i < 2; ++i) { int R, C; stage_rc(tid * 16 + i * 8192, R, C); const int Rb = (R & ~31) + perm32(R & 31);
        voffA[i] = (unsigned)(R * ld + C) * 2u; voffB[i] = (unsigned)(Rb * ld + C) * 2u; }
    const size_t kstep = (size_t)(BK * 2);
    const size_t hstep = (size_t)HALF * ld * 2, tstepB = 2 * hstep;
    const int NT = ld / BK;
    const unsigned ldsw = (unsigned)wid * 1024u;
    const int aoff = lds_byte(wr * 64 + fr, fq * 8), boff = lds_byte(wc * 32 + fr, fq * 8);
#define PG8_SA(b, h) (((b) * 2 + (h)) * HTB)
#define PG8_SB(b, h) ((4 + (b) * 2 + (h)) * HTB)
#define PG8_STAGE(bufoff, gbase, voff) do { _Pragma("unroll") for (int _i = 0; _i < 2; ++_i) \
        __builtin_amdgcn_global_load_lds((const unsigned*)((const char*)(gbase) + (voff)[_i]), (LAS unsigned*)(lds + (bufoff) + ldsw + _i * 8192), 16, 0, 0); } while (0)
#define PG8_LDA(dst, b, h) do { _Pragma("unroll") for (int m = 0; m < 4; ++m) _Pragma("unroll") for (int k = 0; k < 2; ++k) dst[m][k] = *(const LAS bf16x8*)(lds + PG8_SA(b, h) + aoff + m * 2048 + k * 1024); } while (0)
#define PG8_LDB(dst, b, h) do { _Pragma("unroll") for (int n = 0; n < 2; ++n) _Pragma("unroll") for (int k = 0; k < 2; ++k) dst[n][k] = *(const LAS bf16x8*)(lds + PG8_SB(b, h) + boff + n * 2048 + k * 1024); } while (0)
#define PG8_MMA(ai, bj, At, Bt) do { __builtin_amdgcn_s_setprio(1); _Pragma("unroll") for (int m = 0; m < 4; ++m) _Pragma("unroll") for (int n = 0; n < 2; ++n) _Pragma("unroll") for (int k = 0; k < 2; ++k) \
        acc[ai][bj][m][n] = __builtin_amdgcn_mfma_f32_16x16x32_bf16(Bt[n][k], At[m][k], acc[ai][bj][m][n], 0, 0, 0); __builtin_amdgcn_s_setprio(0); } while (0)
#define PG8_WAIT_V(n) asm volatile("s_waitcnt vmcnt(" #n ")" ::: "memory")
#define PG8_WAIT_L(n) asm volatile("s_waitcnt lgkmcnt(" #n ")" ::: "memory")
#define PG8_BAR __builtin_amdgcn_s_barrier()
#define PG8_SCHED __builtin_amdgcn_sched_barrier(0)
    Unit cur, nxt; int ui = 0, kofs, nt, nkofs = 0, nnt = 0, pend = -1;
    if (!get_unit<MODE, SCHED>(0, G, c, nM, nN, NT, cur, kofs, nt)) return;
    f32x4 acc[2][2][4][2];
#pragma unroll
    for (int a = 0; a < 2; ++a)
#pragma unroll
        for (int b = 0; b < 2; ++b)
#pragma unroll
            for (int m = 0; m < 4; ++m)
#pragma unroll
                for (int n = 0; n < 2; ++n) acc[a][b][m][n] = (f32x4){0.f, 0.f, 0.f, 0.f};
    bf16x8 At[4][2], B0[2][2], B1[2][2];
    const char* cA = (const char*)Ab + (size_t)cur.pm * tstepA + (size_t)kofs * 2; const char* cB = (const char*)Bb + (size_t)cur.pn * tstepB + (size_t)kofs * 2;
    if (NEED > 0) { if (WST == C_X) { const int q = cur.pm + 1 < NPANEL ? cur.pm + 1 : cur.pm; dep_wait3(dep.cl + (WST * NPANEL + cur.pm) * 64, (unsigned)NEED, dep.prevmix + 64 * q, dep.prevmix == dep.prep ? 0u : 24u, dep.prep, dep.nprep, dep.tmo, tid); }
                    else dep_wait(dep.cl + (WST * NPANEL + cur.pm) * 64, (unsigned)NEED, dep.tmo, tid); }
    PG8_STAGE(PG8_SB(0, 0), cB, voffB); PG8_STAGE(PG8_SB(0, 1), cB + hstep, voffB); PG8_STAGE(PG8_SA(0, 0), cA, voffA); PG8_STAGE(PG8_SA(0, 1), cA + hstep, voffA);
    if (wr == 1) PG8_BAR;
    PG8_WAIT_V(2); PG8_BAR;
    PG8_STAGE(PG8_SB(1, 0), cB + kstep, voffB); PG8_STAGE(PG8_SA(1, 0), cA + kstep, voffA); PG8_STAGE(PG8_SB(1, 1), cB + hstep + kstep, voffB);
    PG8_WAIT_V(6); PG8_BAR;
    for (;;) {
        const bool has_next = get_unit<MODE, SCHED>(ui + 1, G, c, nM, nN, NT, nxt, nkofs, nnt);
        const char* nA = has_next ? (const char*)Ab + (size_t)nxt.pm * tstepA + (size_t)nkofs * 2 : cA; const char* nB = has_next ? (const char*)Bb + (size_t)nxt.pn * tstepB + (size_t)nkofs * 2 : cB;
        const int ntc = MODE == 0 ? NT : nt;
        for (int t = 0; t < ntc; t += 2) {
            const bool last = (t == ntc - 2);
            const char* a1 = cA + (size_t)(t + 1) * kstep;
            const char* a2 = last ? nA : cA + (size_t)(t + 2) * kstep; const char* b2 = last ? nB : cB + (size_t)(t + 2) * kstep;
            const char* a3 = a2 + kstep; const char* b3 = b2 + kstep;
#if !MK_NOHOOK
            if (NEED > 0 && last && has_next && (MODE == 0 || nxt.sub == 0)) { if (WST == C_X) { const int q = nxt.pm + 1 < NPANEL ? nxt.pm + 1 : nxt.pm; dep_wait3(dep.cl + (WST * NPANEL + nxt.pm) * 64, (unsigned)NEED, dep.prevmix + 64 * q, dep.prevmix == dep.prep ? 0u : 24u, dep.prep, dep.nprep, dep.tmo, tid); }
                else dep_wait(dep.cl + (WST * NPANEL + nxt.pm) * 64, (unsigned)NEED, dep.tmo, tid); }
#endif
            PG8_LDB(B0, 0, 0); PG8_LDB(B1, 0, 1); PG8_SCHED; PG8_LDA(At, 0, 0); PG8_STAGE(PG8_SA(1, 1), a1 + hstep, voffA);
            PG8_WAIT_V(8); PG8_WAIT_L(0); PG8_BAR; PG8_MMA(0, 0, At, B0); PG8_MMA(0, 1, At, B1); PG8_BAR; PG8_SCHED;
            PG8_LDA(At, 0, 1); PG8_STAGE(PG8_SB(0, 0), b2, voffB); PG8_STAGE(PG8_SB(0, 1), b2 + hstep, voffB); PG8_STAGE(PG8_SA(0, 0), a2, voffA);
            PG8_WAIT_V(8); PG8_WAIT_L(0); PG8_BAR; PG8_MMA(1, 0, At, B0); PG8_MMA(1, 1, At, B1); PG8_BAR; PG8_SCHED;
            PG8_LDB(B0, 1, 0); PG8_LDB(B1, 1, 1); PG8_SCHED; PG8_LDA(At, 1, 0); PG8_STAGE(PG8_SA(0, 1), a2 + hstep, voffA);
            PG8_WAIT_V(8); PG8_WAIT_L(0); PG8_BAR; PG8_MMA(0, 0, At, B0); PG8_MMA(0, 1, At, B1); PG8_BAR; PG8_SCHED;
            PG8_LDA(At, 1, 1); PG8_STAGE(PG8_SB(1, 0), b3, voffB); PG8_STAGE(PG8_SB(1, 1), b3 + hstep, voffB); PG8_STAGE(PG8_SA(1, 0), a3, voffA);
            PG8_WAIT_V(8); PG8_WAIT_L(0); PG8_BAR; PG8_MMA(1, 0, At, B0); PG8_MMA(1, 1, At, B1); PG8_BAR; PG8_SCHED;
        }
        if (wr == 0) PG8_BAR;
        if (DST >= 0 && pend >= 0) { PG8_WAIT_V(0); if (lane_id() == 0) __hip_atomic_fetch_add(dep.cl + (DST * NPANEL + pend) * 64, 1u, __ATOMIC_RELAXED, __HIP_MEMORY_SCOPE_AGENT); pend = -1; }
        E(acc, cur, wr, wc, lane);
        if (DST >= 0 && (MODE == 0 || cur.sub == 1)) {
            if (SCHED == 1 && ui == 0) { PG8_WAIT_V(0); if (lane_id() == 0) __hip_atomic_fetch_add(dep.cl + (DST * NPANEL + cur.pm) * 64, 1u, __ATOMIC_RELAXED, __HIP_MEMORY_SCOPE_AGENT); }
            else pend = cur.pm; }
        if (!has_next) break;
        if (MODE == 0 || cur.sub == 1)
#pragma unroll
        for (int a = 0; a < 2; ++a)
#pragma unroll
            for (int b = 0; b < 2; ++b)
#pragma unroll
                for (int m = 0; m < 4; ++m)
#pragma unroll
                    for (int n = 0; n < 2; ++n) acc[a][b][m][n] = (f32x4){0.f, 0.f, 0.f, 0.f};
        cur = nxt; cA = nA; cB = nB; nt = nnt; ++ui;
        if (wr == 1) PG8_BAR;
    }
    PG8_WAIT_V(0);
    if (DST >= 0 && pend >= 0 && lane_id() == 0) __hip_atomic_fetch_add(dep.cl + (DST * NPANEL + pend) * 64, 1u, __ATOMIC_RELAXED, __HIP_MEMORY_SCOPE_AGENT);
    PG8_BAR;
#undef PG8_SA
#undef PG8_SB
#undef PG8_STAGE
#undef PG8_LDA
#undef PG8_LDB
#undef PG8_MMA
#undef PG8_WAIT_V
#undef PG8_WAIT_L
#undef PG8_BAR
#undef PG8_SCHED
}

struct EpiIn {
    unsigned char* ws;
    __device__ __forceinline__ void operator()(const f32x4 (&acc)[2][2][4][2], const Unit& u, int wr, int wc, int lane_) const {
        const int ln = launder_v(lane_), fr = ln & 15, fq = ln >> 4;
        const int lr0 = wr * 64 + fr, cw = wc * 32 + 8 * fq, pn = u.pn;
        const float* rstd = (const float*)(ws + WS_RSA) + u.pm * BM; float* lnpart = (float*)(ws + WS_LNP);
        float rsv[2][4];
#pragma unroll
        for (int ai = 0; ai < 2; ++ai)
#pragma unroll
            for (int m = 0; m < 4; ++m) rsv[ai][m] = rstd[lr0 + ai * HALF + m * 16];
        if (pn < 2) {
            bf16_t* ab = (bf16_t*)(ws + WS_AF + (size_t)u.pm * AF_BLK);
#pragma unroll
            for (int ai = 0; ai < 2; ++ai)
#pragma unroll
                for (int m = 0; m < 4; ++m) { const int lr = lr0 + ai * HALF + m * 16; const float rs = rsv[ai][m];
#pragma unroll
                    for (int bj = 0; bj < 2; ++bj) { const f32x4 v0 = acc[ai][bj][m][0] * rs, v1 = acc[ai][bj][m][1] * rs;
                        u32x4 w; w.x = cvt_pk_bf16(v0[0], v0[1]); w.y = cvt_pk_bf16(v0[2], v0[3]); w.z = cvt_pk_bf16(v1[0], v1[1]); w.w = cvt_pk_bf16(v1[2], v1[3]);
                        { const unsigned vo = (unsigned)(lr * WA + pn * BM + cw) * 2u; if (bj == 0) st16_wt<0>(ab, vo, w); else st16_wt<256>(ab, vo, w); } }
                    asm volatile("" ::: "memory"); }
        } else {
            const int seg = (pn - 2) >> 2, colb = ((pn - 2) & 3) * BM + cw;
            bf16_t* O = (bf16_t*)(ws + WS_BIG + (size_t)u.pm * BIG_BLK + (size_t)seg * SEG_B);
            if (seg < 2) {
#pragma unroll
                for (int ai = 0; ai < 2; ++ai)
#pragma unroll
                    for (int m = 0; m < 4; ++m) { const int lr = lr0 + ai * HALF + m * 16, gr = u.pm * BM + lr; const float rs = rsv[ai][m]; const unsigned vo = (unsigned)(lr * D + colb) * 2u;
                        float s1 = 0.f, s2 = 0.f;
#pragma unroll
                        for (int bj = 0; bj < 2; ++bj) { float v[8];
#pragma unroll
                            for (int j = 0; j < 4; ++j) { v[j] = acc[ai][bj][m][0][j] * rs; v[4 + j] = acc[ai][bj][m][1][j] * rs; }
#pragma unroll
                            for (int j = 0; j < 8; ++j) { const float x = v[j], e = x * (-0.102943240f * (x * x) + -2.30220819f); v[j] = x * __builtin_amdgcn_rcpf(1.0f + __builtin_amdgcn_exp2f(e)); s1 += v[j]; s2 += v[j] * v[j]; }
                            u32x4 w; w.x = cvt_pk_bf16(v[0], v[1]); w.y = cvt_pk_bf16(v[2], v[3]); w.z = cvt_pk_bf16(v[4], v[5]); w.w = cvt_pk_bf16(v[6], v[7]);
                            if (bj == 0) st16_wt<0>(O, vo, w); else st16_wt<256>(O, vo, w); }
                        if (seg == 1) { s1 += shfl_xor_l(s1, 16, ln); s1 += shfl_xor_l(s1, 32, ln); s2 += shfl_xor_l(s2, 16, ln); s2 += shfl_xor_l(s2, 32, ln);
                            if (fq == 0) st8_wt(lnpart + ((size_t)gr * 16 + (pn - 6) * 4 + wc) * 2, (f32x2){s1, s2}); }
                        asm volatile("" ::: "memory"); }
            } else {
#pragma unroll
                for (int ai = 0; ai < 2; ++ai)
#pragma unroll
                    for (int m = 0; m < 4; ++m) { const int lr = lr0 + ai * HALF + m * 16; const float rs = rsv[ai][m] * -1.44269504f; bf16_t* rowp = O + (size_t)lr * D + colb;
#pragma unroll
                        for (int bj = 0; bj < 2; ++bj) { float v[8];
#pragma unroll
                            for (int j = 0; j < 4; ++j) { v[j] = acc[ai][bj][m][0][j] * rs; v[4 + j] = acc[ai][bj][m][1][j] * rs; }
#pragma unroll
                            for (int j = 0; j < 8; ++j) v[j] = __builtin_amdgcn_rcpf(1.0f + __builtin_amdgcn_exp2f(v[j]));
                            u32x4 w; w.x = cvt_pk_bf16(v[0], v[1]); w.y = cvt_pk_bf16(v[2], v[3]); w.z = cvt_pk_bf16(v[4], v[5]); w.w = cvt_pk_bf16(v[6], v[7]);
                            if (bj == 0) st16_wt<0>(O, (unsigned)(lr * D + colb) * 2u, w); else st16_wt<256>(O, (unsigned)(lr * D + colb) * 2u, w); } }
            }
        }
    }
};
struct EpiAB {
    unsigned char* ws; unsigned char* mscr;
    __device__ __forceinline__ void operator()(f32x4 (&acc)[2][2][4][2], const Unit& u, int wr, int wc, int lane_) const {
        const int ln = launder_v(lane_), fr = ln & 15, fq = ln >> 4;
        const int lr0 = wr * 64 + fr, col0 = u.pn * BM + wc * 32 + 8 * fq;
        const bf16_t* SA = (const bf16_t*)(ws + WS_BIG + (size_t)u.pm * BIG_BLK + 2 * SEG_B); const bf16_t* SB = SA + SEG_B / 2;
        bf16_t* mo = (bf16_t*)mscr + (size_t)u.pm * BM * D;
#pragma unroll
        for (int ai = 0; ai < 2; ++ai) {
            u32x4 gb[4][2], ga[4][2];
#pragma unroll
            for (int m = 0; m < 4; ++m)
#pragma unroll
                for (int bj = 0; bj < 2; ++bj) { const size_t off = (size_t)(lr0 + ai * HALF + m * 16) * D + col0 + bj * HALF; gb[m][bj] = *(const u32x4*)(SB + off); if (u.sub == 0) ga[m][bj] = *(const u32x4*)(SA + off); }
#pragma unroll
            for (int m = 0; m < 4; ++m)
#pragma unroll
                for (int bj = 0; bj < 2; ++bj) { const size_t off = (size_t)(lr0 + ai * HALF + m * 16) * D + col0 + bj * HALF; const u32x4 b = gb[m][bj];
                    f32x4 s0 = (f32x4){bf_lo(b.x), bf_hi(b.x), bf_lo(b.y), bf_hi(b.y)}, s1 = (f32x4){bf_lo(b.z), bf_hi(b.z), bf_lo(b.w), bf_hi(b.w)};
#pragma unroll
                    for (int j = 0; j < 4; ++j) { s0[j] = fmaxf(s0[j], 1e-30f); s1[j] = fmaxf(s1[j], 1e-30f); }
                    if (u.sub == 0) { const u32x4 a = ga[m][bj];
#pragma unroll
                        for (int j = 0; j < 4; ++j) { s0[j] = __builtin_amdgcn_rcpf(s0[j]); s1[j] = __builtin_amdgcn_rcpf(s1[j]); }
                        acc[ai][bj][m][0] = acc[ai][bj][m][0] * (s0 * (f32x4){bf_lo(a.x), bf_hi(a.x), bf_lo(a.y), bf_hi(a.y)});
                        acc[ai][bj][m][1] = acc[ai][bj][m][1] * (s1 * (f32x4){bf_lo(a.z), bf_hi(a.z), bf_lo(a.w), bf_hi(a.w)});
                    } else { const f32x4 v0 = acc[ai][bj][m][0] * s0, v1 = acc[ai][bj][m][1] * s1;
                        u32x4 w; w.x = cvt_pk_bf16(v0[0], v0[1]); w.y = cvt_pk_bf16(v0[2], v0[3]); w.z = cvt_pk_bf16(v1[0], v1[1]); w.w = cvt_pk_bf16(v1[2], v1[3]);
                        st16_wt<0>(mo, (unsigned)off * 2u, w); } }
            asm volatile("" ::: "memory"); }
    }
};
struct EpiF {
    unsigned char* fptr; size_t fblk;
    __device__ __forceinline__ void operator()(const f32x4 (&acc)[2][2][4][2], const Unit& u, int wr, int wc, int lane_) const {
        const int ln = launder_v(lane_), fr = ln & 15, fq = ln >> 4;
        const int lr0 = wr * 64 + fr, col0 = u.pn * BM + wc * 32 + 8 * fq;
        bf16_t* fo = (bf16_t*)(fptr + (size_t)u.pm * fblk);
#pragma unroll
        for (int ai = 0; ai < 2; ++ai)
#pragma unroll
            for (int m = 0; m < 4; ++m) { const unsigned vo = (unsigned)((lr0 + ai * HALF + m * 16) * D + col0) * 2u;
#pragma unroll
                for (int bj = 0; bj < 2; ++bj) { const f32x4 v0 = acc[ai][bj][m][0], v1 = acc[ai][bj][m][1];
                    u32x4 w; w.x = cvt_pk_bf16(v0[0], v0[1]); w.y = cvt_pk_bf16(v0[2], v0[3]); w.z = cvt_pk_bf16(v1[0], v1[1]); w.w = cvt_pk_bf16(v1[2], v1[3]);
                    if (bj == 0) st16_wt<0>(fo, vo, w); else st16_wt<256>(fo, vo, w); }
                asm volatile("" ::: "memory"); }
    }
};
struct EpiUp {
    unsigned char* ws;
    __device__ __forceinline__ void operator()(const f32x4 (&acc)[2][2][4][2], const Unit& u, int wr, int wc, int lane_) const {
        const int ln = launder_v(lane_), fr = ln & 15, fq = ln >> 4;
        const int lr0 = wr * 64 + fr, col0 = u.pn * BM + wc * 32 + 8 * fq;
        bf16_t* ro = (bf16_t*)(ws + WS_BIG + (size_t)u.pm * BIG_BLK); const float* rstd = (const float*)(ws + WS_RSB) + u.pm * BM;
        float rsv[2][4];
#pragma unroll
        for (int ai = 0; ai < 2; ++ai)
#pragma unroll
            for (int m = 0; m < 4; ++m) rsv[ai][m] = rstd[lr0 + ai * HALF + m * 16];
#pragma unroll
        for (int ai = 0; ai < 2; ++ai)
#pragma unroll
            for (int m = 0; m < 4; ++m) { const int lr = lr0 + ai * HALF + m * 16; const float rs = rsv[ai][m]; const unsigned vo = (unsigned)(lr * DFF + col0) * 2u;
#pragma unroll
                for (int bj = 0; bj < 2; ++bj) { float v[8];
#pragma unroll
                    for (int j = 0; j < 4; ++j) { v[j] = acc[ai][bj][m][0][j] * rs; v[4 + j] = acc[ai][bj][m][1][j] * rs; }
#pragma unroll
                    for (int j = 0; j < 8; ++j) { v[j] = fmaxf(v[j], 0.f); v[j] = v[j] * v[j]; }
                    u32x4 w; w.x = cvt_pk_bf16(v[0], v[1]); w.y = cvt_pk_bf16(v[2], v[3]); w.z = cvt_pk_bf16(v[4], v[5]); w.w = cvt_pk_bf16(v[6], v[7]);
                    if (bj == 0) st16_wt<0>(ro, vo, w); else st16_wt<256>(ro, vo, w); }
                asm volatile("" ::: "memory"); }
    }
};

__device__ __forceinline__ void transpose_item(const float* W, int K, int N, bf16_t* WT, int ldt, int coff, const float* sc, LAS float* scr, int item, int lane) {
    const int nblk = N / 32, kb = item / nblk, nb = item % nblk, k0 = 64 * kb, n0 = 32 * nb;
    float tv[32];
#pragma unroll
    for (int i = 0; i < 32; ++i) { const int kk = 2 * i + (lane >> 5); tv[i] = W[(size_t)(k0 + kk) * N + n0 + (lane & 31)]; }
#pragma unroll
    for (int i = 0; i < 32; ++i) { const int kk = 2 * i + (lane >> 5); float v = tv[i]; if (sc) v *= sc[k0 + kk]; scr[kk * 33 + (lane & 31)] = v; }
    asm volatile("s_waitcnt lgkmcnt(0)" ::: "memory");
    const int c = lane & 7;
#pragma unroll
    for (int j = 0; j < 4; ++j) { const int n = (lane >> 3) + 8 * j; const LAS float* s = scr + (8 * c) * 33 + n;
        u32x4 o; o.x = cvt_pk_bf16(s[0 * 33], s[1 * 33]); o.y = cvt_pk_bf16(s[2 * 33], s[3 * 33]); o.z = cvt_pk_bf16(s[4 * 33], s[5 * 33]); o.w = cvt_pk_bf16(s[6 * 33], s[7 * 33]);
        st16_wt<0>(WT, (unsigned)((n0 + n) * ldt + coff + k0 + 8 * c) * 2u, o); }
    asm volatile("s_waitcnt lgkmcnt(0)" ::: "memory");
}
struct Params { const float* in[19]; float* out; unsigned char* ws; int ph_lo, ph_hi; };
typedef const __attribute__((address_space(4))) Params Ptrs;
__device__ __forceinline__ Ptrs* kargs() { Ptrs* p = (Ptrs*)__builtin_amdgcn_kernarg_segment_ptr(); asm volatile("" : "+s"(p)); return p; }

__device__ __forceinline__ void prep_layer(Ptrs& P, int l, LAS unsigned char* lds, int wave, int lane, int wg, int nwg) {
    LAS float* scr = (LAS float*)(lds + wave * 8704);
    const int gw = wg * 8 + wave, NGW = nwg * 8;
    unsigned char* wb = P.ws + (size_t)(l & 1) * WBLK;
    const float* w_in = P.in[3] + (size_t)l * D * DIN; const float* w_pg = P.in[4] + (size_t)l * 4 * 128 * 128; const float* pscale = P.in[5] + (size_t)l * WA;
    const float* w_sp = P.in[6] + (size_t)l * 8 * 128 * 128; const float* w_ba = P.in[10] + (size_t)l * WA * D; const float* w_bb = P.in[11] + (size_t)l * D * D;
    const float* w_out = P.in[12] + (size_t)l * D * D; const float* w_up = P.in[13] + (size_t)l * D * DFF; const float* w_dn = P.in[14] + (size_t)l * DFF * D;
    const float* g1 = P.in[15] + (size_t)l * D; const float* g3 = P.in[17] + (size_t)l * D;
    constexpr int I_IN = (D / 64) * (DIN / 32), I_BB = (D / 64) * (D / 32), I_OUT = I_BB, I_UP = (D / 64) * (DFF / 32), I_DN = (DFF / 64) * (D / 32), I_FOLD = 4 * 32 * 16, I_SP = 256;
    constexpr int NITEMS = I_IN + I_BB + I_OUT + I_UP + I_DN + I_FOLD + I_SP;
    for (int it = gw; it < NITEMS; it += NGW) {
        int r = it;
        if (r < I_IN) { transpose_item(w_in, D, DIN, (bf16_t*)(wb + WOFF_IN), D, 0, g1, scr, r, lane); continue; } r -= I_IN;
        if (r < I_BB) { transpose_item(w_bb, D, D, (bf16_t*)(wb + WOFF_AB), KAB, 512, nullptr, scr, r, lane); continue; } r -= I_BB;
        if (r < I_OUT) { transpose_item(w_out, D, D, (bf16_t*)(wb + WOFF_OUT), D, 0, nullptr, scr, r, lane); continue; } r -= I_OUT;
        if (r < I_UP) { transpose_item(w_up, D, DFF, (bf16_t*)(wb + WOFF_UP), D, 0, g3, scr, r, lane); continue; } r -= I_UP;
        if (r < I_DN) { transpose_item(w_dn, DFF, D, (bf16_t*)(wb + WOFF_DN), DFF, 0, nullptr, scr, r, lane); continue; } r -= I_DN;
        if (r < I_FOLD) {
            const int g = r >> 9, cb = (r >> 4) & 31, nb = r & 15, n = nb * 64 + lane;
            float acc[4] = {0.f, 0.f, 0.f, 0.f};
            const float* pg = w_pg + ((size_t)g * 128 + cb * 4) * 128;
            for (int d0 = 0; d0 < 128; d0 += 16) { float wv[16];
#pragma unroll
                for (int q = 0; q < 16; ++q) wv[q] = w_ba[(size_t)(g * 128 + d0 + q) * D + n];
#pragma unroll
                for (int q = 0; q < 16; ++q) { const float x = wv[q] * pscale[g * 128 + d0 + q];
#pragma unroll
                    for (int j = 0; j < 4; ++j) acc[j] += pg[j * 128 + d0 + q] * x; } }
            u32x2 o; o.x = cvt_pk_bf16(acc[0], acc[1]); o.y = cvt_pk_bf16(acc[2], acc[3]);
            st8b_wt(wb + WOFF_AB, (unsigned)(n * KAB + g * 128 + cb * 4) * 2u, o); continue; } r -= I_FOLD;
        {
            const int e0 = r * 512 + lane * 8, s0 = e0 & 127, t = (e0 >> 7) & 127;
            const f32x4 x0 = *(const f32x4*)(w_sp + e0), x1 = *(const f32x4*)(w_sp + e0 + 4); float v[8] = {x0[0], x0[1], x0[2], x0[3], x1[0], x1[1], x1[2], x1[3]};
#pragma unroll
            for (int j = 0; j < 8; ++j) v[j] = (s0 + j <= t) ? v[j] : 0.f;
            u32x4 o; o.x = cvt_pk_bf16(v[0], v[1]); o.y = cvt_pk_bf16(v[2], v[3]); o.z = cvt_pk_bf16(v[4], v[5]); o.w = cvt_pk_bf16(v[6], v[7]);
            st16_wt<0>(wb + WOFF_SP, (unsigned)e0 * 2u, o); }
    }
}

__device__ __forceinline__ unsigned* ticket_ptr(unsigned char* ws, int l, int k) { return cnt_ptr(ws, 5, 0) + 64 * (8 + l * 3 + k); }
__device__ __forceinline__ int claim_bcast(unsigned v, volatile LAS unsigned* slot, int tid) { if (tid == 0) slot[0] = v; __syncthreads(); const int r = (int)slot[0]; __syncthreads(); return r; }

__device__ __forceinline__ void phase_r0(Ptrs& P, int tid, int wave, int lane) {
    bf16_t* xb = (bf16_t*)(P.ws + WS_XB); float* rsa = (float*)(P.ws + WS_RSA);
    for (int it = blockIdx.x; it < NPANEL * 8; it += gridDim.x) {
        for (int i = 0; i < 4; ++i) { const int m = it * 32 + wave * 4 + i;
            const float* src = m < MP ? P.in[0] + (size_t)m * D : P.in[1] + (size_t)(m - MP) * D;
            f32x4 v[4]; float ss = 0.f;
#pragma unroll
            for (int j = 0; j < 4; ++j) { v[j] = *(const f32x4*)(src + 256 * j + 4 * lane); ss += (v[j][0] * v[j][0] + v[j][1] * v[j][1]) + (v[j][2] * v[j][2] + v[j][3] * v[j][3]); }
            ss = wave_sum(ss, lane);
#pragma unroll
            for (int j = 0; j < 4; ++j) { u32x2 w; w.x = cvt_pk_bf16(v[j][0], v[j][1]); w.y = cvt_pk_bf16(v[j][2], v[j][3]); st8b_wt(xb, (unsigned)(m * D + 256 * j + 4 * lane) * 2u, w); }
            if (lane == 0) __hip_atomic_store((unsigned*)(rsa + m), __float_as_uint(1.0f / sqrtf(ss * (1.0f / D) + EPS)), __ATOMIC_RELAXED, __HIP_MEMORY_SCOPE_AGENT); }
        dep_done_wt(cnt_ptr(P.ws, 0, C_X) + 64 * (it >> 3), tid, 2u);
    }
}
__device__ __forceinline__ void phase_res(Ptrs& P, const float* g, float* rs_out, const unsigned char* fptr, const size_t fblk, const unsigned* cwait, unsigned* cdone, unsigned* tmo, const bool final_out, unsigned* ticket, LAS unsigned char* lds, int tid, int wave, int lane) {
    float* yo = P.out + OUT_X; bf16_t* xb = (bf16_t*)(P.ws + WS_XB);
    f32x4 gv[4];
#pragma unroll
    for (int j = 0; j < 4; ++j) gv[j] = *(const f32x4*)(g + 256 * j + 4 * lane);
    volatile LAS unsigned* slot = (volatile LAS unsigned*)(lds + 131072 + 1024);
    int it = claim_bcast(tid == 0 ? __hip_atomic_fetch_add(ticket, 1u, __ATOMIC_RELAXED, __HIP_MEMORY_SCOPE_AGENT) : 0u, slot, tid);
    while (it < NPANEL * 8) {
        unsigned nx = 0u; if (tid == 0) nx = __hip_atomic_fetch_add(ticket, 1u, __ATOMIC_RELAXED, __HIP_MEMORY_SCOPE_AGENT);
        const int pm = it >> 3;
        dep_wait(cwait + 64 * pm, 32u, tmo, tid);
        const bf16_t* fb = (const bf16_t*)(fptr + (size_t)pm * fblk);
        for (int i = 0; i < 4; ++i) { const int lr = (it & 7) * 32 + wave * 4 + i, m = pm * BM + lr;
            f32x4 fv[4], xv[4]; float ss = 0.f;
#pragma unroll
            for (int j = 0; j < 4; ++j) { const u32x2 fw = *(const u32x2*)(fb + (size_t)lr * D + 256 * j + 4 * lane); fv[j] = (f32x4){bf_lo(fw.x), bf_hi(fw.x), bf_lo(fw.y), bf_hi(fw.y)};
                const u32x2 xw = *(const u32x2*)(xb + (size_t)m * D + 256 * j + 4 * lane); xv[j] = (f32x4){bf_lo(xw.x), bf_hi(xw.x), bf_lo(xw.y), bf_hi(xw.y)};
                ss += (fv[j][0] * fv[j][0] + fv[j][1] * fv[j][1]) + (fv[j][2] * fv[j][2] + fv[j][3] * fv[j][3]); }
            const float c = 1.0f / sqrtf(wave_sum(ss, lane) * (1.0f / D) + EPS); float s2 = 0.f;
#pragma unroll
            for (int j = 0; j < 4; ++j) { xv[j] = xv[j] + fv[j] * c * gv[j]; s2 += (xv[j][0] * xv[j][0] + xv[j][1] * xv[j][1]) + (xv[j][2] * xv[j][2] + xv[j][3] * xv[j][3]); }
            if (final_out) {
#pragma unroll
                for (int j = 0; j < 4; ++j) *(f32x4*)(yo + (size_t)m * D + 256 * j + 4 * lane) = xv[j];
            } else {
                s2 = wave_sum(s2, lane);
#pragma unroll
                for (int j = 0; j < 4; ++j) { u32x2 w; w.x = cvt_pk_bf16(xv[j][0], xv[j][1]); w.y = cvt_pk_bf16(xv[j][2], xv[j][3]); st8b_wt(xb, (unsigned)(m * D + 256 * j + 4 * lane) * 2u, w); }
                if (lane == 0) __hip_atomic_store((unsigned*)(rs_out + m), __float_as_uint(1.0f / sqrtf(s2 * (1.0f / D) + EPS)), __ATOMIC_RELAXED, __HIP_MEMORY_SCOPE_AGENT); } }
        if (cdone) dep_done_wt(cdone + 64 * pm, tid, 2u);
        it = claim_bcast(nx, slot, tid);
    }
}

constexpr int VT_LD = 136;
__device__ __forceinline__ void sgu_item(Ptrs& P, int l, int item, LAS unsigned char* lds, int tid, int wave, int lane) {
    const int chunk = item >> 3, h = item & 7, row0 = chunk * 128, pm = chunk >> 1, lr0 = (chunk & 1) * 128; const bool is_sample = chunk >= 128;
    const int fr = lane & 15, fq = lane >> 4;
    LAS float* st = (LAS float*)lds;
    LAS bf16_t* VT = (LAS bf16_t*)(lds + 1024);
    const float* lnpart = (const float*)(P.ws + WS_LNP);
    const bf16_t* ub = (const bf16_t*)(P.ws + WS_BIG + (size_t)pm * BIG_BLK) + (size_t)lr0 * D; const bf16_t* gvb = ub + SEG_B / 2;
    const bf16_t* wsp = (const bf16_t*)(P.ws + (size_t)(l & 1) * WBLK + WOFF_SP);
    bf16_t* dyb = (bf16_t*)(P.ws + WS_DY + (size_t)pm * DY_BLK) + (size_t)lr0 * KAB;
    const float* lng = P.in[8] + (size_t)l * D; const float* lnb = P.in[9] + (size_t)l * D; const float* bsp = P.in[7] + (size_t)l * 8 * 128;
    const int w = wave, k1 = w >> 1, k0 = is_sample ? k1 : 0;
    bf16x8 af[4];
#pragma unroll
    for (int k = 0; k < 4; ++k) { af[k] = (bf16x8){0, 0, 0, 0, 0, 0, 0, 0};
        if (!is_sample) { if (k <= k1) af[k] = *(const bf16x8*)(wsp + ((size_t)(h * 128 + 16 * w + fr)) * 128 + 32 * k + 8 * fq); }
        else if (k == k1 && fq == 2 * (w & 1) + (fr >> 3)) af[k] = *(const bf16x8*)(wsp + ((size_t)(h * 128 + (fr & 7))) * 128); }
    const int tl = 16 * w + fr; const float bias = bsp[h * 128 + (is_sample ? (fr & 7) : tl)];
    u32x2 uu[8];
#pragma unroll
    for (int n = 0; n < 8; ++n) uu[n] = *(const u32x2*)(ub + (size_t)tl * D + h * 128 + 16 * n + 4 * fq);
    u32x4 gr0[2], gr1[2]; f32x4 lga[2], lgb[2], lba[2], lbb[2];
#pragma unroll
    for (int it = 0; it < 2; ++it) { const int idx = tid + it * 512, p = idx & 63, cg8 = idx >> 6, s = 2 * p, col = h * 128 + cg8 * 8;
        gr0[it] = *(const u32x4*)(gvb + (size_t)s * D + col); gr1[it] = *(const u32x4*)(gvb + (size_t)(s + 1) * D + col);
        lga[it] = *(const f32x4*)(lng + col); lgb[it] = *(const f32x4*)(lng + col + 4); lba[it] = *(const f32x4*)(lnb + col); lbb[it] = *(const f32x4*)(lnb + col + 4); }
    if (tid < 128) { const float* p = lnpart + (size_t)(row0 + tid) * 32; float s1 = 0.f, s2 = 0.f;
#pragma unroll
        for (int j = 0; j < 8; ++j) { const f32x4 q = *(const f32x4*)(p + 4 * j); s1 += q[0] + q[2]; s2 += q[1] + q[3]; }
        const float mean = s1 * (1.0f / D), var = fmaxf(s2 * (1.0f / D) - mean * mean, 0.f);
        st[2 * tid] = mean; st[2 * tid + 1] = 1.0f / sqrtf(var + EPS); }
    __syncthreads();
#pragma unroll
    for (int it = 0; it < 2; ++it) { const int idx = tid + it * 512, p = idx & 63, cg8 = idx >> 6, s = 2 * p, col = h * 128 + cg8 * 8;
        const u32x4 r0 = gr0[it], r1 = gr1[it];
        const f32x4 ga = lga[it], gb = lgb[it], ba = lba[it], bb = lbb[it];
        const float m0 = st[2 * s], q0 = st[2 * s + 1], m1 = st[2 * s + 2], q1 = st[2 * s + 3];
        float a0[8] = {bf_lo(r0.x), bf_hi(r0.x), bf_lo(r0.y), bf_hi(r0.y), bf_lo(r0.z), bf_hi(r0.z), bf_lo(r0.w), bf_hi(r0.w)};
        float a1[8] = {bf_lo(r1.x), bf_hi(r1.x), bf_lo(r1.y), bf_hi(r1.y), bf_lo(r1.z), bf_hi(r1.z), bf_lo(r1.w), bf_hi(r1.w)};
        const float gg[8] = {ga[0], ga[1], ga[2], ga[3], gb[0], gb[1], gb[2], gb[3]}, bq[8] = {ba[0], ba[1], ba[2], ba[3], bb[0], bb[1], bb[2], bb[3]};
#pragma unroll
        for (int j = 0; j < 8; ++j) { a0[j] = (a0[j] - m0) * q0 * gg[j] + bq[j]; a1[j] = (a1[j] - m1) * q1 * gg[j] + bq[j]; }
        if (is_sample) { float* vo = P.out + OUT_VS + ((size_t)l * MS + (row0 - MP) + s) * D + col;
            *(f32x4*)(vo) = (f32x4){a0[0], a0[1], a0[2], a0[3]}; *(f32x4*)(vo + 4) = (f32x4){a0[4], a0[5], a0[6], a0[7]};
            *(f32x4*)(vo + D) = (f32x4){a1[0], a1[1], a1[2], a1[3]}; *(f32x4*)(vo + D + 4) = (f32x4){a1[4], a1[5], a1[6], a1[7]}; }
#pragma unroll
        for (int j = 0; j < 8; ++j) *(LAS unsigned*)(VT + (cg8 * 8 + j) * VT_LD + s) = cvt_pk_bf16(a0[j], a1[j]);
    }
    __syncthreads();
    f32x4 acc[8];
#pragma unroll
    for (int n = 0; n < 8; ++n) acc[n] = (f32x4){0.f, 0.f, 0.f, 0.f};
#pragma unroll
    for (int k = 0; k < 4; ++k) { if (k >= k0 && k <= k1) {
#pragma unroll
        for (int n = 0; n < 8; ++n) { const bf16x8 bfr = *(const LAS bf16x8*)(VT + (16 * n + fr) * VT_LD + 32 * k + 8 * fq);
            acc[n] = __builtin_amdgcn_mfma_f32_16x16x32_bf16(bfr, af[k], acc[n], 0, 0, 0); } } }
#pragma unroll
    for (int n = 0; n < 8; ++n) { const int col = h * 128 + 16 * n + 4 * fq;
        const float y0 = bf_lo(uu[n].x) * (acc[n][0] + bias), y1 = bf_hi(uu[n].x) * (acc[n][1] + bias), y2 = bf_lo(uu[n].y) * (acc[n][2] + bias), y3 = bf_hi(uu[n].y) * (acc[n][3] + bias);
        u32x2 o; o.x = cvt_pk_bf16(y0, y1); o.y = cvt_pk_bf16(y2, y3); st8b_wt(dyb, (unsigned)(tl * KAB + 512 + col) * 2u, o); }
}
__device__ __forceinline__ f32x4 ld_a(const unsigned char* ws, int gr, int ch) {
    const u32x2 w = *(const u32x2*)((const bf16_t*)(ws + WS_AF + (size_t)(gr >> 8) * AF_BLK) + (size_t)(gr & 255) * WA + ch);
    return (f32x4){bf_lo(w.x), bf_hi(w.x), bf_lo(w.y), bf_hi(w.y)};
}
template <int W>
__device__ __forceinline__ void pool_w(Ptrs& P, int l, int chunk, int g, int tid) {
    const int cq = tid & 31, rs = tid >> 5, ch = g * 128 + cq * 4;
    const unsigned char* ws = P.ws;
    f32x4 rows[W + 7];
    if (chunk < 128) {
        const int rb = chunk * 128, t0 = (chunk & 15) * 128, tl0 = rs * 8;
        bf16_t* dyb = (bf16_t*)(P.ws + WS_DY + (size_t)(chunk >> 1) * DY_BLK) + (size_t)((chunk & 1) * 128) * KAB;
#pragma unroll
        for (int k = 0; k < W + 7; ++k) { const int tl = tl0 - (W - 1) + k; rows[k] = (t0 + tl >= 0) ? ld_a(ws, rb + tl, ch) : (f32x4){0.f, 0.f, 0.f, 0.f}; }
        f32x4 S = (f32x4){0.f, 0.f, 0.f, 0.f};
#pragma unroll
        for (int k = 0; k < W - 1; ++k) S = S + rows[k];
#pragma unroll
        for (int i = 0; i < 8; ++i) { const int tl = tl0 + i, pos = t0 + tl; const f32x4 cur = rows[W - 1 + i];
            S = S + cur; const float inv = 1.0f / (float)(pos + 1 < W ? pos + 1 : W); const f32x4 d = S * inv - cur;
            u32x2 o; o.x = cvt_pk_bf16(d[0], d[1]); o.y = cvt_pk_bf16(d[2], d[3]); st8b_wt(dyb, (unsigned)(tl * KAB + ch) * 2u, o);
            if ((chunk & 15) == 15 && tl >= 113) *(f32x4*)(P.out + OUT_PP + (((size_t)l * 8 + (chunk >> 4)) * 15 + (tl - 113)) * WA + ch) = cur;
            S = S - rows[i]; }
    } else {
        const int seq = (chunk - 128) * 16 + rs; const float* sp = P.in[2] + ((size_t)l * 128 + seq) * 15 * WA + ch; const int gr0 = MP + seq * 8;
        bf16_t* dyb = (bf16_t*)(P.ws + WS_DY + (size_t)(chunk >> 1) * DY_BLK) + (size_t)((chunk & 1) * 128) * KAB;
        float* po = P.out + OUT_PS + ((size_t)l * 128 + seq) * 15 * WA + ch;
#pragma unroll
        for (int k = 0; k < W + 7; ++k) { const int e = 15 - (W - 1) + k; rows[k] = e < 15 ? *(const f32x4*)(sp + (size_t)e * WA) : ld_a(ws, gr0 + e - 15, ch); }
#pragma unroll
        for (int i = 0; i < 7; ++i) *(f32x4*)(po + (size_t)i * WA) = *(const f32x4*)(sp + (size_t)(8 + i) * WA);
        f32x4 S = (f32x4){0.f, 0.f, 0.f, 0.f};
#pragma unroll
        for (int k = 0; k < W - 1; ++k) S = S + rows[k];
#pragma unroll
        for (int i = 0; i < 8; ++i) { const f32x4 cur = rows[W - 1 + i];
            S = S + cur; const f32x4 d = S * (1.0f / (float)W) - cur;
            u32x2 o; o.x = cvt_pk_bf16(d[0], d[1]); o.y = cvt_pk_bf16(d[2], d[3]); st8b_wt(dyb, (unsigned)((rs * 8 + i) * KAB + ch) * 2u, o);
            *(f32x4*)(po + (size_t)(7 + i) * WA) = cur;
            S = S - rows[i]; }
    }
}
__device__ __forceinline__ void pool_item(Ptrs& P, int l, int item, int tid) {
    const int chunk = item >> 2, g = item & 3;
    if (g == 0) pool_w<2>(P, l, chunk, g, tid); else if (g == 1) pool_w<4>(P, l, chunk, g, tid); else if (g == 2) pool_w<8>(P, l, chunk, g, tid); else pool_w<16>(P, l, chunk, g, tid);
}
__device__ __forceinline__ void phase_mix(Ptrs& P, int l, LAS unsigned char* lds, unsigned* tmo, int tid, int wave, int lane) {
    const unsigned* cw = cnt_ptr(P.ws, l, C_G1); unsigned* ticket = ticket_ptr(P.ws, l, 0);
    volatile LAS unsigned* slot = (volatile LAS unsigned*)(lds + 131072 + 1024);
    int it = claim_bcast(tid == 0 ? __hip_atomic_fetch_add(ticket, 1u, __ATOMIC_RELAXED, __HIP_MEMORY_SCOPE_AGENT) : 0u, slot, tid);
    while (it < NPANEL * 12) {
        unsigned nx = 0u; if (tid == 0) nx = __hip_atomic_fetch_add(ticket, 1u, __ATOMIC_RELAXED, __HIP_MEMORY_SCOPE_AGENT);
        const int pm = it / 12, r = it - pm * 12;
        if (r < 8) { const int chunk = pm * 2 + (r >> 2), h0 = (r & 3) * 2;
            dep_wait(cw + 64 * pm, 144u, tmo, tid);
            sgu_item(P, l, chunk * 8 + h0, lds, tid, wave, lane); __syncthreads(); sgu_item(P, l, chunk * 8 + h0 + 1, lds, tid, wave, lane);
        } else { const int chunk = pm * 2 + ((r - 8) >> 1), g0 = ((r - 8) & 1) * 2;
            if ((chunk & 1) == 0 && chunk < 128 && (chunk & 15) != 0) dep_wait2(cw + 64 * pm, cw + 64 * (pm - 1), 144u, tmo, tid); else dep_wait(cw + 64 * pm, 144u, tmo, tid);
            pool_item(P, l, chunk * 4 + g0, tid); pool_item(P, l, chunk * 4 + g0 + 1, tid); }
        dep_done_wt(cnt_ptr(P.ws, l, C_MIX) + 64 * pm, tid, 2u);
        it = claim_bcast(nx, slot, tid);
    }
}
}

__global__ void __launch_bounds__(512, 2) mk_fwd(Params prm) {
    extern __shared__ __attribute__((aligned(16))) unsigned char lds_raw[];
    LAS unsigned char* lds = (LAS unsigned char*)lds_raw;
    cg::grid_group grid = cg::this_grid();
    volatile LAS unsigned* bst = (volatile LAS unsigned*)(lds + 131072 + 512);
    if (threadIdx.x < 2) bst[threadIdx.x] = 0u;
    __syncthreads();
    (void)xcd_barrier_post((unsigned*)(prm.ws + WS_BAR), bst);
    if (prm.ph_hi < 0) grid.sync();
    constexpr int nM = M / BM;
    const int wave = __builtin_amdgcn_readfirstlane(threadIdx.x >> 6);
    constexpr size_t TS1K = (size_t)BM * D * 2;
    {
        const int lane = launder_v(lane_id()), tid = wave * 64 + lane;
        Ptrs& P = *kargs();
        phase_r0(P, tid, wave, lane); prep_layer(P, 0, lds, wave, lane, blockIdx.x, gridDim.x);
        xcd_barrier((unsigned*)(P.ws + WS_BAR), (volatile LAS unsigned*)(lds + 131072 + 512), tid);
    }
    for (int l = 0; l < DEPTH; ++l) {
        for (int s = 0; s < 9; ++s) {
            const int lane = launder_v(lane_id()), tid = wave * 64 + lane;
            Ptrs& P = *kargs(); unsigned char* ws = P.ws; unsigned char* wb = ws + (size_t)(l & 1) * WBLK;
            unsigned* tmo = (unsigned*)(ws + WS_BAR) + XB_TMO;
            const unsigned* prepc = cnt_ptr(ws, 5, 0) + 64 * l;
            Dep dp{cnt_ptr(ws, l, 0), tmo, l >= 1 ? cnt_ptr(ws, l - 1, C_MIX) : prepc, prepc, l >= 1 ? (gridDim.x == 256 ? 208u : gridDim.x) : 0u};
            if (s == 0 && ((MK_SMASK >> 0) & 1)) {
                EpiIn E{ws};
                gemm_phase<0, 7, C_X, 16, C_G1, EpiIn>(wave, lds, (const bf16_t*)(ws + WS_XB), TS1K, (const bf16_t*)(wb + WOFF_IN), D, nM, DIN / BM, E, dp);
            } else if (s == 2 && ((MK_SMASK >> 2) & 1)) {
                phase_mix(P, l, lds, tmo, tid, wave, lane);
            } else if (s == 3 && ((MK_SMASK >> 3) & 1)) {
                EpiAB E{ws, (unsigned char*)P.out + OUT_MSCR};
                gemm_phase<1, 3, C_MIX, 24, C_G2, EpiAB>(wave, lds, (const bf16_t*)(ws + WS_DY), DY_BLK, (const bf16_t*)(wb + WOFF_AB), KAB, nM, D / BM, E, dp);
            } else if (s == 4 && ((MK_SMASK >> 4) & 1)) {
                EpiF E{(unsigned char*)P.out, AF_BLK};
                gemm_phase<0, 4, C_G2, 32, C_G3, EpiF>(wave, lds, (const bf16_t*)((unsigned char*)P.out + OUT_MSCR), TS1K, (const bf16_t*)(wb + WOFF_OUT), D, nM, D / BM, E, dp);
                if (l + 1 < DEPTH) {
                    const int c = blockIdx.x, v = (c & 7) * 32 + (c >> 3), h = v >> 4, p = v - h - 1; const bool sub = gridDim.x == 256;
                    if (!sub || ((v & 15) != 0 && p >= 32)) {
                        if (l >= 1) dep_wait_many(cnt_ptr(ws, l - 1, C_G5), NPANEL, 32u, tmo, tid, [](int i) { return i; });
                        if (sub) prep_layer(P, l + 1, lds, wave, lane, p - 32, 208); else prep_layer(P, l + 1, lds, wave, lane, blockIdx.x, gridDim.x);
                        dep_done_wt(cnt_ptr(ws, 5, 0) + 64 * (l + 1), tid); }
                }
            } else if (s == 5 && ((MK_SMASK >> 5) & 1)) {
                phase_res(P, P.in[16] + (size_t)l * D, (float*)(ws + WS_RSB), (const unsigned char*)P.out, AF_BLK, cnt_ptr(ws, l, C_G3), cnt_ptr(ws, l, C_R1), tmo, false, ticket_ptr(ws, l, 1), lds, tid, wave, lane);
                if (l + 1 == DEPTH) xcd_barrier((unsigned*)(ws + WS_BAR), (volatile LAS unsigned*)(lds + 131072 + 512), tid);
            } else if (s == 6 && ((MK_SMASK >> 6) & 1)) {
                EpiUp E{ws};
                gemm_phase<0, 1, C_R1, 16, C_G4, EpiUp>(wave, lds, (const bf16_t*)(ws + WS_XB), TS1K, (const bf16_t*)(wb + WOFF_UP), D, nM, DFF / BM, E, dp);
            } else if (s == 7 && ((MK_SMASK >> 7) & 1)) {
                EpiF E{ws + WS_DY, DY_BLK};
                gemm_phase<0, 2, C_G4, 128, C_G5, EpiF>(wave, lds, (const bf16_t*)(ws + WS_BIG), BIG_BLK, (const bf16_t*)(wb + WOFF_DN), DFF, nM, D / BM, E, dp);
            } else if (s == 8 && ((MK_SMASK >> 8) & 1)) {
                phase_res(P, P.in[18] + (size_t)l * D, (float*)(ws + WS_RSA), ws + WS_DY, DY_BLK, cnt_ptr(ws, l, C_G5), l + 1 < DEPTH ? cnt_ptr(ws, l + 1, C_X) : nullptr, tmo, l + 1 == DEPTH, ticket_ptr(ws, l, 2), lds, tid, wave, lane);
            }
            __syncthreads();
        }
    }
}

extern "C" void kernel_launch(void* const* d_in, const int* in_sizes, int n_in, void* d_out, int out_size, void* d_ws, size_t ws_size, hipStream_t stream) {
    static int grid = 0;
    if (grid == 0) {
        if (n_in != 19 || in_sizes[0] != MP * D || in_sizes[1] != MS * D || ws_size < WS_END || (size_t)out_size != OUT_VS + (size_t)DEPTH * MS * D) {
            fprintf(stderr, "kernel_launch: unexpected shapes / workspace (n_in %d, ws %zu, out %d); nothing launched\n", n_in, ws_size, out_size); grid = -1; return; }
        int dev = 0, cus = 0, per_cu = 0;
        if (hipGetDevice(&dev) != hipSuccess || hipDeviceGetAttribute(&cus, hipDeviceAttributeMultiprocessorCount, dev) != hipSuccess) { grid = -1; return; }
        if (hipFuncSetAttribute((const void*)mk_fwd, hipFuncAttributeMaxDynamicSharedMemorySize, LDS_BYTES) != hipSuccess) { fprintf(stderr, "kernel_launch: hipFuncSetAttribute failed\n"); grid = -1; return; }
        if (hipOccupancyMaxActiveBlocksPerMultiprocessor(&per_cu, (const void*)mk_fwd, 512, LDS_BYTES) != hipSuccess || per_cu < 1) { fprintf(stderr, "kernel_launch: occupancy query says %d\n", per_cu); per_cu = 1; }
        (void)hipGetLastError();
        grid = cus * 1;
    }
    if (grid < 0) return;
    if (hipMemsetAsync((char*)d_ws + WS_BAR, 0, CTL_BYTES, stream) != hipSuccess) { fprintf(stderr, "kernel_launch: memset failed\n"); return; }
    Params a{};
    for (int i = 0; i < 19; ++i) a.in[i] = (const float*)d_in[i];
    a.out = (float*)d_out; a.ws = (unsigned char*)d_ws;
    a.ph_lo = 0; a.ph_hi = 1;
    void* args[] = {&a};
    hipError_t e = hipLaunchCooperativeKernel((const void*)mk_fwd, dim3(grid), dim3(512), args, LDS_BYTES, stream);
    if (e != hipSuccess) fprintf(stderr, "cooperative launch failed: %s (grid %d)\n", hipGetErrorString(e), grid);
}
```
